# Optimizing an MI355X kernel written in HIP

```python
import math
import jax, jax.numpy as jnp
from jax import lax
import numpy as np

D_MODEL = 1024
BATCH = 2
SEQ = 16384
DEPTH = 1

HEAD_DIM = 128
N_Q_HEADS = 8
N_KV_HEADS = 2
Q_PER_KV = N_Q_HEADS // N_KV_HEADS
ATTN_WIDTH = N_Q_HEADS * HEAD_DIM
KV_WIDTH = N_KV_HEADS * HEAD_DIM
FOURIER_GROUPS = 4
FOURIER_GROUP_DIM = 128
FOURIER_WIDTH = FOURIER_GROUPS * FOURIER_GROUP_DIM
IN_WIDTH = ATTN_WIDTH + 2 * KV_WIDTH + ATTN_WIDTH + 2 * FOURIER_WIDTH
GRID_W = 64
AXIS_DIM = HEAD_DIM // 2
ROPE_THETA = 10000.0
Q_BLOCK = 128
NORM_EPS = 1e-6

kernel_name = "hybrid_axial_gqa_fourier_gated_merge"


def rms_norm(x, g):
    xf = x.astype(jnp.float32)
    y = xf * lax.rsqrt(jnp.mean(xf * xf, axis=-1, keepdims=True) + NORM_EPS)
    return (y * g.astype(jnp.float32)).astype(x.dtype)


def axial_rope_tables(seq_len):
    rows = seq_len // GRID_W
    row = jnp.repeat(jnp.arange(rows, dtype=jnp.float32), GRID_W)
    col = jnp.tile(jnp.arange(GRID_W, dtype=jnp.float32), rows)
    inv = ROPE_THETA ** (-jnp.arange(0, AXIS_DIM, 2, dtype=jnp.float32) / AXIS_DIM)
    ang_r = row[:, None] * inv[None, :]
    ang_c = col[:, None] * inv[None, :]
    ang_r = jnp.concatenate([ang_r, ang_r], axis=-1)
    ang_c = jnp.concatenate([ang_c, ang_c], axis=-1)
    return jnp.cos(ang_r), jnp.sin(ang_r), jnp.cos(ang_c), jnp.sin(ang_c)


def rotate_half_apply(x, cos, sin):
    x1, x2 = jnp.split(x, 2, axis=-1)
    rot = jnp.concatenate([-x2, x1], axis=-1)
    return x * cos[:, None, :] + rot * sin[:, None, :]


def axial_rope(x, tables):
    cos_r, sin_r, cos_c, sin_c = tables
    xf = x.astype(jnp.float32)
    xr, xc = jnp.split(xf, 2, axis=-1)
    out = jnp.concatenate([rotate_half_apply(xr, cos_r, sin_r),
                           rotate_half_apply(xc, cos_c, sin_c)], axis=-1)
    return out.astype(x.dtype)


def bidirectional_gqa(q, k, v):
    b, s = q.shape[0], q.shape[1]
    nb = s // Q_BLOCK
    scale = 1.0 / math.sqrt(HEAD_DIM)
    qb = q.reshape(b, nb, Q_BLOCK, N_KV_HEADS, Q_PER_KV, HEAD_DIM).transpose(1, 0, 2, 3, 4, 5)

    def one_block(qi):
        sc = jnp.einsum('bqhgd,bkhd->bhgqk', qi, k).astype(jnp.float32) * scale
        p = jax.nn.softmax(sc, axis=-1)
        return jnp.einsum('bhgqk,bkhd->bqhgd', p.astype(v.dtype), v)

    o = lax.map(one_block, qb)
    return o.transpose(1, 0, 2, 3, 4, 5).reshape(b, s, ATTN_WIDTH)


def fourier_mix(u):
    b, s, _ = u.shape
    ug = u.astype(jnp.float32).reshape(b, s, FOURIER_GROUPS, FOURIER_GROUP_DIM)
    f = jnp.fft.fft2(ug, axes=(1, 3), norm='ortho').real
    return f.reshape(b, s, FOURIER_WIDTH).astype(u.dtype)


def setup_inputs(seed: int = 0) -> dict:
    key = jax.random.key(seed)
    ks = jax.random.split(key, 11)
    f32 = jnp.float32
    x = jax.random.normal(ks[0], (BATCH, SEQ, D_MODEL), f32)
    norm_g = 1.0 + 0.02 * jax.random.normal(ks[1], (DEPTH, D_MODEL), f32)
    w_in = jax.random.normal(ks[2], (DEPTH, D_MODEL, IN_WIDTH), f32) * D_MODEL ** -0.5
    q_norm_g = 1.0 + 0.02 * jax.random.normal(ks[3], (DEPTH, HEAD_DIM), f32)
    k_norm_g = 1.0 + 0.02 * jax.random.normal(ks[4], (DEPTH, HEAD_DIM), f32)
    w_attn_proj = jax.random.normal(ks[5], (DEPTH, ATTN_WIDTH, D_MODEL), f32) * ATTN_WIDTH ** -0.5
    w_fourier_proj = jax.random.normal(ks[6], (DEPTH, FOURIER_WIDTH, D_MODEL), f32) * FOURIER_WIDTH ** -0.5
    w_merge = jax.random.normal(ks[7], (DEPTH, D_MODEL, 2 * D_MODEL), f32) * D_MODEL ** -0.5
    b_merge = 0.01 * jax.random.normal(ks[8], (DEPTH, 2 * D_MODEL), f32)
    w_out = jax.random.normal(ks[9], (DEPTH, D_MODEL, D_MODEL), f32) * D_MODEL ** -0.5
    return {"x": x, "norm_g": norm_g, "w_in": w_in, "q_norm_g": q_norm_g,
            "k_norm_g": k_norm_g, "w_attn_proj": w_attn_proj,
            "w_fourier_proj": w_fourier_proj, "w_merge": w_merge,
            "b_merge": b_merge, "w_out": w_out}


def reference(x, norm_g, w_in, q_norm_g, k_norm_g, w_attn_proj, w_fourier_proj,
              w_merge, b_merge, w_out):
    b, s, _ = x.shape
    tables = axial_rope_tables(s)
    splits = np.cumsum([ATTN_WIDTH, KV_WIDTH, KV_WIDTH, ATTN_WIDTH, FOURIER_WIDTH]).tolist()
    for l in range(DEPTH):
        h = rms_norm(x, norm_g[l])
        proj = jnp.einsum('bsd,de->bse', h, w_in[l])
        q, k, v, z_attn, u_f, z_f = jnp.split(proj, splits, axis=-1)

        q = rms_norm(q.reshape(b, s, N_Q_HEADS, HEAD_DIM), q_norm_g[l])
        k = rms_norm(k.reshape(b, s, N_KV_HEADS, HEAD_DIM), k_norm_g[l])
        v = v.reshape(b, s, N_KV_HEADS, HEAD_DIM)
        q = axial_rope(q, tables).reshape(b, s, N_KV_HEADS, Q_PER_KV, HEAD_DIM)
        k = axial_rope(k, tables)
        a = bidirectional_gqa(q, k, v) * jax.nn.silu(z_attn)
        y_attn = jnp.einsum('bse,ed->bsd', a, w_attn_proj[l])

        f = fourier_mix(u_f) * jax.nn.silu(z_f)
        y_four = jnp.einsum('bse,ed->bsd', f, w_fourier_proj[l])

        gates = jax.nn.sigmoid(jnp.einsum('bsd,de->bse', h, w_merge[l]) + b_merge[l])
        g_attn, g_four = jnp.split(gates, 2, axis=-1)
        merged = g_attn * y_attn + g_four * y_four
        x = x + jnp.einsum('bsd,de->bse', merged, w_out[l])
    return x
```

```cpp
#include <hip/hip_runtime.h>
#include <hip/hip_bf16.h>
#include <hip/hip_cooperative_groups.h>
#include <cstdio>
#include <cstdint>
#include <type_traits>
namespace cg = cooperative_groups;
namespace pg8 {
#define PG8_LAS __attribute__((address_space(3)))
typedef unsigned short bf16_t;
typedef short bf16x8 __attribute__((ext_vector_type(8)));
typedef float f32x4 __attribute__((ext_vector_type(4)));
typedef unsigned u32x4 __attribute__((ext_vector_type(4)));
constexpr int BM = 256, BK = 64, HALF = 128, HTB = HALF * BK * 2  , STAGE_BYTES = 8 * HTB, NXCD = 8, WGM = 8;

__host__ __device__ __forceinline__ int lds_byte(int r, int c) { const int st = (r >> 4) * 2 + (c >> 5), rr = r & 15, cc = c & 31, ob = rr * 64 + cc * 2; return st * 1024 + (ob ^ (((ob >> 9) & 1) << 5)); }
__host__ __device__ __forceinline__ void stage_rc(int b, int& R, int& C) { const int st = b / 1024, sb = b % 1024, swz = sb ^ (((sb >> 9) & 1) << 5); R = (st >> 1) * 16 + swz / 64; C = (st & 1) * 32 + (swz % 64) / 2; }
__host__ __device__ __forceinline__ int perm32(int rho) { const int n = rho >> 4, i = rho & 15; return 8 * (i >> 2) + 4 * n + (i & 3); }

struct Unit { int pm, pn; };
struct Gemm { const bf16_t* A; const bf16_t* Bt; int M, N, K, lda, ldb; };

struct StaticOrder {
    int nM, nN, nwg, G, c;
    __host__ __device__ void init(int M, int N, int G_, int c_) { nM = M / BM; nN = N / BM; nwg = nM * nN; G = G_; c = c_; }
    __host__ __device__ bool next(int i, Unit& u) const {
        const long L = (long)i * G + c; if (L >= nwg) return false;
        int wgid = (int)L; { const int q = nwg / NXCD, r = nwg % NXCD, xcd = wgid % NXCD, off = wgid / NXCD; wgid = (xcd < r ? xcd * (q + 1) : r * (q + 1) + (xcd - r) * q) + off; }
        const int nig = WGM * nN, gid = wgid / nig, fm = gid * WGM, gsz = (nM - fm) < WGM ? (nM - fm) : WGM;
        u.pm = fm + ((wgid % nig) % gsz); u.pn = (wgid % nig) / gsz; return true;
    }
    __device__ __forceinline__ void a_ready(const Unit&) const {}
    __device__ __forceinline__ void done(const Unit&) const {}
};

__device__ __forceinline__ unsigned cvt_pk_bf16(float lo, float hi) { unsigned r; asm volatile("v_cvt_pk_bf16_f32 %0, %1, %2" : "=v"(r) : "v"(lo), "v"(hi)); return r; }
template <class Epi, class Sched, bool ALIGN_EPI = false, bool SP2 = false>
__device__ __forceinline__ void gemm_phase(PG8_LAS unsigned char* lds, const Gemm g, const Sched& S, const Epi& E, const int wid_s) {
    int tid_; asm volatile("v_mbcnt_lo_u32_b32 %0, -1, 0\n\tv_mbcnt_hi_u32_b32 %0, -1, %0" : "=v"(tid_)); tid_ += wid_s * 64;
    const int tid = tid_, wid = __builtin_amdgcn_readfirstlane(tid >> 6), lane = tid & 63, wr = wid >> 2, wc = wid & 3, fr = lane & 15, fq = lane >> 4;
    const int K = g.K, nt = K / BK;
    unsigned voffA[2], voffB[2];
#pragma unroll
    for (int i = 0; i < 2; ++i) { int R, C; stage_rc(tid * 16 + i * 8192, R, C); const int Rb = Epi::PERM ? ((R & ~31) + perm32(R & 31)) : R;
        voffA[i] = (unsigned)(R * g.lda + C) * 2u; voffB[i] = (unsigned)(Rb * g.ldb + C) * 2u; }
    const size_t kstep = (size_t)(BK * 2);
    const size_t hstepA = (size_t)HALF * g.lda * 2, hstepB = (size_t)HALF * g.ldb * 2;
    const size_t tstepA = 2 * hstepA, tstepB = 2 * hstepB;
    const unsigned ldsw = (unsigned)wid * 1024u;
    const int aoff = lds_byte(wr * 64 + fr, fq * 8), boff = lds_byte(wc * 32 + fr, fq * 8);
#define PG8_SA(b, h) (((b) * 2 + (h)) * HTB)
#define PG8_SB(b, h) ((4 + (b) * 2 + (h)) * HTB)
#define PG8_STAGE(bufoff, gbase, voff) do { _Pragma("unroll") for (int _i = 0; _i < 2; ++_i) \
        __builtin_amdgcn_global_load_lds((const unsigned*)((const char*)(gbase) + (voff)[_i]), (PG8_LAS unsigned*)(lds + (bufoff) + ldsw + _i * 8192), 16, 0, 0); } while (0)
#define PG8_LDA(dst, b, h) do { _Pragma("unroll") for (int m = 0; m < 4; ++m) _Pragma("unroll") for (int k = 0; k < 2; ++k) dst[m][k] = *(const PG8_LAS bf16x8*)(lds + PG8_SA(b, h) + aoff + m * 2048 + k * 1024); } while (0)
#define PG8_LDB(dst, b, h) do { _Pragma("unroll") for (int n = 0; n < 2; ++n) _Pragma("unroll") for (int k = 0; k < 2; ++k) dst[n][k] = *(const PG8_LAS bf16x8*)(lds + PG8_SB(b, h) + boff + n * 2048 + k * 1024); } while (0)
#define PG8_MMA(ai, bj, At, Bt) do { __builtin_amdgcn_s_setprio(1); _Pragma("unroll") for (int m = 0; m < 4; ++m) _Pragma("unroll") for (int n = 0; n < 2; ++n) _Pragma("unroll") for (int k = 0; k < 2; ++k) \
        acc[ai][bj][m][n] = __builtin_amdgcn_mfma_f32_16x16x32_bf16(Bt[n][k], At[m][k], acc[ai][bj][m][n], 0, 0, 0); __builtin_amdgcn_s_setprio(0); } while (0)
#define PG8_WAIT_V(n) asm volatile("s_waitcnt vmcnt(" #n ")" ::: "memory")
#define PG8_WAIT_L(n) asm volatile("s_waitcnt lgkmcnt(" #n ")" ::: "memory")
#define PG8_BAR __builtin_amdgcn_s_barrier()
#define PG8_SCHED __builtin_amdgcn_sched_barrier(0)
    Unit cur, nxt; int ui = 0;
    if (!S.next(0, cur)) return;
    f32x4 acc[2][2][4][2];
#pragma unroll
    for (int a = 0; a < 2; ++a)
#pragma unroll
        for (int b = 0; b < 2; ++b)
#pragma unroll
            for (int m = 0; m < 4; ++m)
#pragma unroll
                for (int n = 0; n < 2; ++n) acc[a][b][m][n] = (f32x4){0.f, 0.f, 0.f, 0.f};
    bf16x8 At[4][2], B0[2][2], B1[2][2];
    const char* cA = (const char*)g.A + (size_t)cur.pm * tstepA; const char* cB = (const char*)g.Bt + (size_t)cur.pn * tstepB;
    S.a_ready(cur);
    if constexpr (SP2) {
        PG8_STAGE(PG8_SB(0, 0), cB, voffB); PG8_STAGE(PG8_SB(0, 1), cB + hstepB, voffB); PG8_STAGE(PG8_SA(0, 0), cA, voffA); PG8_STAGE(PG8_SA(0, 1), cA + hstepA, voffA);
        if (wr == 1) PG8_BAR;
        PG8_WAIT_V(2); PG8_BAR;
        PG8_STAGE(PG8_SB(1, 0), cB + kstep, voffB); PG8_STAGE(PG8_SA(1, 0), cA + kstep, voffA); PG8_STAGE(PG8_SB(1, 1), cB + hstepB + kstep, voffB);
        PG8_WAIT_V(6); PG8_BAR;
    } else {
        PG8_STAGE(PG8_SB(0, 0), cB, voffB); PG8_STAGE(PG8_SA(0, 0), cA, voffA); PG8_STAGE(PG8_SB(0, 1), cB + hstepB, voffB); PG8_STAGE(PG8_SA(0, 1), cA + hstepA, voffA);
        if (wr == 1) PG8_BAR;
        PG8_WAIT_V(4); PG8_BAR;
        PG8_STAGE(PG8_SB(1, 0), cB + kstep, voffB); PG8_STAGE(PG8_SA(1, 0), cA + kstep, voffA); PG8_STAGE(PG8_SB(1, 1), cB + hstepB + kstep, voffB);
        PG8_WAIT_V(6); PG8_BAR;
    }
    for (;;) {
        const bool has_next = S.next(ui + 1, nxt);
        const char* nA = has_next ? (const char*)g.A + (size_t)nxt.pm * tstepA : cA; const char* nB = has_next ? (const char*)g.Bt + (size_t)nxt.pn * tstepB : cB;
        for (int t = 0; t < nt; t += 2) {
            const bool last = (t == nt - 2);
            const char* a1 = cA + (size_t)(t + 1) * kstep;
            const char* a2 = last ? nA : cA + (size_t)(t + 2) * kstep; const char* b2 = last ? nB : cB + (size_t)(t + 2) * kstep;
            const char* a3 = a2 + kstep; const char* b3 = b2 + kstep;
            if (last && has_next) S.a_ready(nxt);
            if constexpr (Epi::HAS_MID) { if (t == Epi::MID_T) { asm volatile("" ::: "memory"); E.mid(acc, cur, wr, wc, fr, fq); asm volatile("" ::: "memory"); } }
            if constexpr (SP2) {
            PG8_LDB(B0, 0, 0); PG8_LDB(B1, 0, 1); PG8_SCHED; PG8_LDA(At, 0, 0); PG8_STAGE(PG8_SA(1, 1), a1 + hstepA, voffA);
            PG8_WAIT_V(8); PG8_WAIT_L(0); PG8_BAR; PG8_MMA(0, 0, At, B0); PG8_MMA(0, 1, At, B1); PG8_BAR; PG8_SCHED;
            PG8_LDA(At, 0, 1); PG8_STAGE(PG8_SB(0, 0), b2, voffB); PG8_STAGE(PG8_SB(0, 1), b2 + hstepB, voffB); PG8_STAGE(PG8_SA(0, 0), a2, voffA);
            PG8_WAIT_V(8); PG8_WAIT_L(0); PG8_BAR; PG8_MMA(1, 0, At, B0); PG8_MMA(1, 1, At, B1); PG8_BAR; PG8_SCHED;
            PG8_LDB(B0, 1, 0); PG8_LDB(B1, 1, 1); PG8_SCHED; PG8_LDA(At, 1, 0); PG8_STAGE(PG8_SA(0, 1), a2 + hstepA, voffA);
            PG8_WAIT_V(8); PG8_WAIT_L(0); PG8_BAR; PG8_MMA(0, 0, At, B0); PG8_MMA(0, 1, At, B1); PG8_BAR; PG8_SCHED;
            PG8_LDA(At, 1, 1); PG8_STAGE(PG8_SB(1, 0), b3, voffB); PG8_STAGE(PG8_SB(1, 1), b3 + hstepB, voffB); PG8_STAGE(PG8_SA(1, 0), a3, voffA);
            PG8_WAIT_V(8); PG8_WAIT_L(0); PG8_BAR; PG8_MMA(1, 0, At, B0); PG8_MMA(1, 1, At, B1); PG8_BAR; PG8_SCHED;
            } else {
            PG8_LDB(B0, 0, 0); PG8_SCHED; PG8_LDA(At, 0, 0); PG8_STAGE(PG8_SA(1, 1), a1 + hstepA, voffA);
            PG8_WAIT_L(8); PG8_BAR; PG8_WAIT_L(0); PG8_MMA(0, 0, At, B0); PG8_BAR; PG8_SCHED;
            PG8_LDB(B1, 0, 1); PG8_STAGE(PG8_SB(0, 0), b2, voffB);
            PG8_BAR; PG8_WAIT_L(0); PG8_MMA(0, 1, At, B1); PG8_BAR;
            PG8_LDA(At, 0, 1); PG8_STAGE(PG8_SA(0, 0), a2, voffA);
            PG8_BAR; PG8_WAIT_L(0); PG8_MMA(1, 0, At, B0); PG8_BAR; PG8_SCHED;
            PG8_STAGE(PG8_SB(0, 1), b2 + hstepB, voffB);
            PG8_WAIT_V(6); PG8_BAR; PG8_MMA(1, 1, At, B1); PG8_BAR;
            PG8_LDB(B0, 1, 0); PG8_SCHED; PG8_LDA(At, 1, 0); PG8_STAGE(PG8_SA(0, 1), a2 + hstepA, voffA);
            PG8_WAIT_L(8); PG8_BAR; PG8_WAIT_L(0); PG8_MMA(0, 0, At, B0); PG8_BAR; PG8_SCHED;
            PG8_LDB(B1, 1, 1); PG8_STAGE(PG8_SB(1, 0), b3, voffB);
            PG8_BAR; PG8_WAIT_L(0); PG8_MMA(0, 1, At, B1); PG8_BAR;
            PG8_LDA(At, 1, 1); PG8_STAGE(PG8_SA(1, 0), a3, voffA);
            PG8_BAR; PG8_WAIT_L(0); PG8_MMA(1, 0, At, B0); PG8_BAR; PG8_SCHED;
            PG8_STAGE(PG8_SB(1, 1), b3 + hstepB, voffB);
            PG8_WAIT_V(6); PG8_BAR; PG8_MMA(1, 1, At, B1); PG8_BAR;
            }
        }
        if constexpr (ALIGN_EPI) { if (wr == 0) PG8_BAR; }
        if constexpr (!Epi::AFTER_DRAIN) { E(acc, cur, wr, wc, fr, fq); S.done(cur); }
        if (!has_next) break;
#pragma unroll
        for (int a = 0; a < 2; ++a)
#pragma unroll
            for (int b = 0; b < 2; ++b)
#pragma unroll
                for (int m = 0; m < 4; ++m)
#pragma unroll
                    for (int n = 0; n < 2; ++n) acc[a][b][m][n] = (f32x4){0.f, 0.f, 0.f, 0.f};
        cur = nxt; cA = nA; cB = nB; ++ui;
        if constexpr (ALIGN_EPI) { if (wr == 1) PG8_BAR; }
    }
    PG8_WAIT_V(0);
    if constexpr (!ALIGN_EPI) { if (wr == 0) PG8_BAR; }
    PG8_BAR;
    if constexpr (Epi::AFTER_DRAIN) { E.fused(acc, cur, wr, wc, fr, fq, lds, wid, lane); S.done(cur); }
#undef PG8_SA
#undef PG8_SB
#undef PG8_STAGE
#undef PG8_LDA
#undef PG8_LDB
#undef PG8_MMA
#undef PG8_WAIT_V
#undef PG8_WAIT_L
#undef PG8_BAR
#undef PG8_SCHED
}
}

constexpr int BATCH = 2, SEQ = 16384, DM = 1024, MROWS = BATCH * SEQ;
constexpr int LDP = 6144;
constexpr int C_Q = 0, C_K = 1024, C_V = 1280, C_ZA = 1536, C_ZR = 2560, C_ZI = 3072, C_ZF = 3584, C_G = 4096;
constexpr int C_MG = 1536;
constexpr int LDAF = 1536;
constexpr size_t MiB = 1u << 20;
constexpr size_t WS_P1 = 0, WS_AF = 384 * MiB, WS_W1T = 480 * MiB, WS_WCAT = 492 * MiB, WS_WOUT = 495 * MiB, WS_TAB = 497 * MiB, WS_CTL = WS_TAB + 262144 + 4096  , WS_END = 498 * MiB;
constexpr int LDS_BYTES = 147456;
constexpr float NORM_EPS = 1e-6f;

typedef unsigned short bf16_t;
typedef short bf16x8 __attribute__((ext_vector_type(8)));
typedef short s16x4 __attribute__((ext_vector_type(4)));
typedef float f32x4 __attribute__((ext_vector_type(4)));
typedef float f32x16 __attribute__((ext_vector_type(16)));
typedef unsigned u32x4 __attribute__((ext_vector_type(4)));
typedef unsigned u32x2 __attribute__((ext_vector_type(2)));
#define LAS __attribute__((address_space(3)))
#define LDS_WAIT() asm volatile("s_waitcnt lgkmcnt(0)" ::: "memory")
#define SBAR() __builtin_amdgcn_sched_barrier(0)
__device__ __forceinline__ int lane_id_asm() { int r; asm volatile("v_mbcnt_lo_u32_b32 %0, -1, 0\n\tv_mbcnt_hi_u32_b32 %0, -1, %0" : "=v"(r)); return r; }
#define MYTID(w) ((w) * 64 + lane_id_asm())

__device__ __forceinline__ unsigned cvtpk(float lo, float hi) { unsigned r; asm volatile("v_cvt_pk_bf16_f32 %0, %1, %2" : "=v"(r) : "v"(lo), "v"(hi)); return r; }
__device__ __forceinline__ bf16_t f2bf(float f) { return (bf16_t)(cvtpk(f, f) & 0xffffu); }
__device__ __forceinline__ float bf2f(bf16_t h) { return __uint_as_float((unsigned)h << 16); }
__device__ __forceinline__ float bflo(unsigned w) { return __uint_as_float(w << 16); }
__device__ __forceinline__ float bfhi(unsigned w) { return __uint_as_float(w & 0xffff0000u); }
__device__ __forceinline__ float sigm(float v) { return __builtin_amdgcn_rcpf(1.0f + __builtin_amdgcn_exp2f(-1.4426950408889634f * v)); }
__device__ __forceinline__ float sin_rev(float rev) { return __builtin_amdgcn_sinf(rev); }
__device__ __forceinline__ float cos_rev(float rev) { return __builtin_amdgcn_cosf(rev); }

namespace pg8 {
struct EpiG1 {
    static constexpr bool PERM = true, AFTER_DRAIN = false, HAS_MID = false; static constexpr int MID_T = 0;
    bf16_t* O; const float* bias;
    __device__ __forceinline__ void mid(f32x4 (&)[2][2][4][2], const Unit&, int, int, int, int) const {}
    __device__ __forceinline__ void operator()(const f32x4 (&acc)[2][2][4][2], const Unit& u, int wr, int wc, int fr, int fq) const {
        const int pn = u.pn;
        const int mode = (pn >= 16) ? 2 : (((pn >= 6 && pn < 10) || pn >= 14) ? 1 : 0);
        const int row0 = u.pm * BM + wr * 64 + fr, col0 = pn * BM + wc * 32 + 8 * fq;
        f32x4 bv[2][2];
#pragma unroll
        for (int bj = 0; bj < 2; ++bj)
#pragma unroll
            for (int n = 0; n < 2; ++n) bv[bj][n] = (mode == 2) ? *(const f32x4*)(bias + (col0 - C_G) + bj * HALF + 4 * n) : (f32x4){0.f, 0.f, 0.f, 0.f};
#pragma unroll
        for (int ai = 0; ai < 2; ++ai)
#pragma unroll
            for (int m = 0; m < 4; ++m) { bf16_t* rowp = O + (size_t)(row0 + ai * HALF + m * 16) * LDP + col0;
#pragma unroll
                for (int bj = 0; bj < 2; ++bj) { f32x4 v0 = acc[ai][bj][m][0] + bv[bj][0], v1 = acc[ai][bj][m][1] + bv[bj][1];
                    if (mode == 1) {
#pragma unroll
                        for (int e = 0; e < 4; ++e) { v0[e] = v0[e] * sigm(v0[e]); v1[e] = v1[e] * sigm(v1[e]); } }
                    else if (mode == 2) {
#pragma unroll
                        for (int e = 0; e < 4; ++e) { v0[e] = sigm(v0[e]); v1[e] = sigm(v1[e]); } }
                    u32x4 w; w.x = cvt_pk_bf16(v0[0], v0[1]); w.y = cvt_pk_bf16(v0[2], v0[3]); w.z = cvt_pk_bf16(v1[0], v1[1]); w.w = cvt_pk_bf16(v1[2], v1[3]);
                    *(u32x4*)(rowp + bj * HALF) = w; } }
    }
};
struct EpiG3 {
    static constexpr bool PERM = true, AFTER_DRAIN = false, HAS_MID = true; static constexpr int MID_T = 16;
    const bf16_t* P; bf16_t* O;
    __device__ __forceinline__ void mid(f32x4 (&acc)[2][2][4][2], const Unit& u, int wr, int wc, int fr, int fq) const {
        const int row0 = u.pm * BM + wr * 64 + fr, col0 = u.pn * BM + wc * 32 + 8 * fq;
#pragma unroll
        for (int ai = 0; ai < 2; ++ai)
#pragma unroll
            for (int m = 0; m < 4; ++m) { const bf16_t* gp = P + (size_t)(row0 + ai * HALF + m * 16) * LDP + C_G + col0;
#pragma unroll
                for (int bj = 0; bj < 2; ++bj) { const u32x4 ga = *(const u32x4*)(gp + bj * HALF), gf = *(const u32x4*)(gp + 1024 + bj * HALF);
                    f32x4 r0, r1;
                    r0[0] = bflo(ga.x) * __builtin_amdgcn_rcpf(fmaxf(bflo(gf.x), 1e-30f)); r0[1] = bfhi(ga.x) * __builtin_amdgcn_rcpf(fmaxf(bfhi(gf.x), 1e-30f));
                    r0[2] = bflo(ga.y) * __builtin_amdgcn_rcpf(fmaxf(bflo(gf.y), 1e-30f)); r0[3] = bfhi(ga.y) * __builtin_amdgcn_rcpf(fmaxf(bfhi(gf.y), 1e-30f));
                    r1[0] = bflo(ga.z) * __builtin_amdgcn_rcpf(fmaxf(bflo(gf.z), 1e-30f)); r1[1] = bfhi(ga.z) * __builtin_amdgcn_rcpf(fmaxf(bfhi(gf.z), 1e-30f));
                    r1[2] = bflo(ga.w) * __builtin_amdgcn_rcpf(fmaxf(bflo(gf.w), 1e-30f)); r1[3] = bfhi(ga.w) * __builtin_amdgcn_rcpf(fmaxf(bfhi(gf.w), 1e-30f));
                    acc[ai][bj][m][0] *= r0; acc[ai][bj][m][1] *= r1; } }
    }
    __device__ __forceinline__ void operator()(const f32x4 (&acc)[2][2][4][2], const Unit& u, int wr, int wc, int fr, int fq) const {
        const int row0 = u.pm * BM + wr * 64 + fr, col0 = u.pn * BM + wc * 32 + 8 * fq;
#pragma unroll
        for (int ai = 0; ai < 2; ++ai)
#pragma unroll
            for (int m = 0; m < 4; ++m) { const size_t ro = (size_t)(row0 + ai * HALF + m * 16) * LDP + col0;
#pragma unroll
                for (int bj = 0; bj < 2; ++bj) { const u32x4 gf = *(const u32x4*)(P + ro + C_G + 1024 + bj * HALF);
                    const f32x4 v0 = acc[ai][bj][m][0], v1 = acc[ai][bj][m][1];
                    u32x4 w; w.x = cvt_pk_bf16(v0[0] * bflo(gf.x), v0[1] * bfhi(gf.x)); w.y = cvt_pk_bf16(v0[2] * bflo(gf.y), v0[3] * bfhi(gf.y));
                    w.z = cvt_pk_bf16(v1[0] * bflo(gf.z), v1[1] * bfhi(gf.z)); w.w = cvt_pk_bf16(v1[2] * bflo(gf.w), v1[3] * bfhi(gf.w));
                    *(u32x4*)(O + ro + bj * HALF) = w; } }
    }
};
struct EpiG4 {
    static constexpr bool PERM = true, AFTER_DRAIN = false, HAS_MID = false; static constexpr int MID_T = 0;
    const float* X; float* O;
    __device__ __forceinline__ void mid(f32x4 (&)[2][2][4][2], const Unit&, int, int, int, int) const {}
    __device__ __forceinline__ void operator()(const f32x4 (&acc)[2][2][4][2], const Unit& u, int wr, int wc, int fr, int fq) const {
        const int row0 = u.pm * BM + wr * 64 + fr, col0 = u.pn * BM + wc * 32 + 8 * fq;
#pragma unroll
        for (int ai = 0; ai < 2; ++ai)
#pragma unroll
            for (int m = 0; m < 4; ++m) { const size_t ro = (size_t)(row0 + ai * HALF + m * 16) * DM + col0;
#pragma unroll
                for (int bj = 0; bj < 2; ++bj) { const f32x4 x0 = *(const f32x4*)(X + ro + bj * HALF), x1 = *(const f32x4*)(X + ro + bj * HALF + 4);
                    *(f32x4*)(O + ro + bj * HALF) = x0 + acc[ai][bj][m][0]; *(f32x4*)(O + ro + bj * HALF + 4) = x1 + acc[ai][bj][m][1]; } }
    }
};
}

namespace att {
constexpr int D = 128, NW = 8, QBLK = 32, KVBLK = 64;
constexpr float SCALE = 0.088388347648318440f;
constexpr float THR = 8.f;
constexpr int LDQ = LDP, LDK = LDP;
constexpr size_t SHM_V = KVBLK * D * 2, SHM_K = KVBLK * D * 2, SHM_ATTN = 2 * SHM_V + 2 * SHM_K + NW * 64 * 4;
#define KSWZ(row, colB) ((row) * 256 + ((colB) ^ (((row) & 15) << 4)))
__device__ __forceinline__ int crow(int r, int hi) { return (r & 3) + 8 * (r >> 2) + 4 * hi; }
constexpr float THRL = THR * 1.4426950408889634f;
template <bool FIRST, bool DOEXP = true>
__device__ __forceinline__ void partialSM(f32x16& p0, f32x16& p1, float& m_reg, f32x16& negm, float& alpha, const bool track = true) {
  if (!FIRST && !track) { alpha = 1.f;
    if (DOEXP) {
#pragma unroll
      for (int r = 0; r < 16; ++r) p0[r] = __builtin_amdgcn_exp2f(p0[r]); }
    return; }
  float pmax = p0[0];
#pragma unroll
  for (int r = 1; r < 16; ++r) pmax = fmaxf(pmax, p0[r]);
#pragma unroll
  for (int r = 0; r < 16; ++r) pmax = fmaxf(pmax, p1[r]);
  { auto rr = __builtin_amdgcn_permlane32_swap(__float_as_uint(pmax), __float_as_uint(pmax), false, false);
    pmax = fmaxf(__uint_as_float(rr[0]), __uint_as_float(rr[1])); }
  if (!FIRST && __builtin_expect(__all(pmax <= THRL), 1)) { alpha = 1.f; }
  else { const float dl = FIRST ? pmax : fmaxf(pmax, 0.f); m_reg += dl; alpha = FIRST ? 1.f : __builtin_amdgcn_exp2f(-dl);
#pragma unroll
    for (int r = 0; r < 16; ++r) { p0[r] -= dl; p1[r] -= dl; }
#pragma unroll
    for (int r = 0; r < 16; ++r) negm[r] = -m_reg;
    asm volatile("" : "+v"(negm)); }
  if (DOEXP) {
#pragma unroll
    for (int r = 0; r < 16; ++r) p0[r] = __builtin_amdgcn_exp2f(p0[r]); }
}
__device__ __forceinline__ void finishSM(f32x16& p0, f32x16& p1, float alpha, float& l_reg, bf16x8& pa0, bf16x8& pa1, bf16x8& pa2, bf16x8& pa3) {
#pragma unroll
  for (int r = 0; r < 16; ++r) p1[r] = __builtin_amdgcn_exp2f(p1[r]);
  float ps = 0;
#pragma unroll
  for (int r = 0; r < 16; ++r) ps += p0[r];
#pragma unroll
  for (int r = 0; r < 16; ++r) ps += p1[r];
  asm volatile("" : "+v"(ps));
  l_reg = l_reg * alpha + ps;
#define PK4(P, BASE, OUT) do { u32x4 w = {cvtpk(P[BASE + 0], P[BASE + 1]), cvtpk(P[BASE + 2], P[BASE + 3]), cvtpk(P[BASE + 4], P[BASE + 5]), cvtpk(P[BASE + 6], P[BASE + 7])}; \
    OUT = *reinterpret_cast<bf16x8*>(&w); } while (0)
  PK4(p0, 0, pa0); PK4(p0, 8, pa1); PK4(p1, 0, pa2); PK4(p1, 8, pa3);
#undef PK4
}
__device__ __forceinline__ void qkt(f32x16& p0, f32x16& p1, const bf16_t* Ks, const bf16x8* qr, const f32x16& negm, int r32, int hi) {
#pragma unroll
  for (int d0 = 0; d0 < 8; ++d0) { int cb = (d0 * 16 + hi * 8) * 2;
    bf16x8 b0 = *reinterpret_cast<const bf16x8*>((const char*)Ks + KSWZ(r32, cb));
    bf16x8 b1 = *reinterpret_cast<const bf16x8*>((const char*)Ks + KSWZ(32 + r32, cb));
    if (d0 == 0) { p0 = __builtin_amdgcn_mfma_f32_32x32x16_bf16(b0, qr[0], negm, 0, 0, 0); p1 = __builtin_amdgcn_mfma_f32_32x32x16_bf16(b1, qr[0], negm, 0, 0, 0); }
    else { p0 = __builtin_amdgcn_mfma_f32_32x32x16_bf16(b0, qr[d0], p0, 0, 0, 0); p1 = __builtin_amdgcn_mfma_f32_32x32x16_bf16(b1, qr[d0], p1, 0, 0, 0); } }
}
__device__ __forceinline__ int v_st(int k, int c) { const int kk = (k & ~0xC) | ((k & 4) << 1) | ((k & 8) >> 1); return ((kk >> 3) * 4 + (c >> 5)) * 512 + ((kk & 7) * 32 + (c & 31)) * 2; }
__device__ __forceinline__ int v_st_nat(int k, int c) { return ((k >> 3) * 4 + (c >> 5)) * 512 + ((k & 7) * 32 + (c & 31)) * 2; }
__device__ __forceinline__ int v_rd_base(int lane) { return ((lane & 3) << 3) | (((lane >> 2) & 3) << 6) | (((lane >> 4) & 1) << 5) | (((lane >> 5) & 1) << 8); }
constexpr int v_rd_off(int d0, int ks, int half) { return d0 * 512 + ks * 4096 + half * 2048; }
template <int OFF> __device__ __forceinline__ s16x4 tr_read(int vb) {
  s16x4 r; asm volatile("ds_read_b64_tr_b16 %0, %1 offset:%2" : "=&v"(r) : "v"(vb), "i"(OFF) : "memory"); return r;
}
template <int D0> __device__ __forceinline__ void pv_one(f32x16& od, int vb, bf16x8 pa0, bf16x8 pa1, bf16x8 pa2, bf16x8 pa3) {
  const s16x4 l0 = tr_read<v_rd_off(D0, 0, 0)>(vb), h0 = tr_read<v_rd_off(D0, 0, 1)>(vb), l1 = tr_read<v_rd_off(D0, 1, 0)>(vb), h1 = tr_read<v_rd_off(D0, 1, 1)>(vb);
  const s16x4 l2 = tr_read<v_rd_off(D0, 2, 0)>(vb), h2 = tr_read<v_rd_off(D0, 2, 1)>(vb), l3 = tr_read<v_rd_off(D0, 3, 0)>(vb), h3 = tr_read<v_rd_off(D0, 3, 1)>(vb);
  asm volatile("s_waitcnt lgkmcnt(0)" ::: "memory"); SBAR();
#define PK(L, H) (bf16x8){L[0], L[1], L[2], L[3], H[0], H[1], H[2], H[3]}
  od = __builtin_amdgcn_mfma_f32_32x32x16_bf16(pa0, PK(l0, h0), od, 0, 0, 0);
  od = __builtin_amdgcn_mfma_f32_32x32x16_bf16(pa1, PK(l1, h1), od, 0, 0, 0);
  od = __builtin_amdgcn_mfma_f32_32x32x16_bf16(pa2, PK(l2, h2), od, 0, 0, 0);
  od = __builtin_amdgcn_mfma_f32_32x32x16_bf16(pa3, PK(l3, h3), od, 0, 0, 0);
#undef PK
}
__device__ __forceinline__ void pv_d0(f32x16* o, int vb, bf16x8 pa0, bf16x8 pa1, bf16x8 pa2, bf16x8 pa3) {
  pv_one<0>(o[0], vb, pa0, pa1, pa2, pa3); pv_one<1>(o[1], vb, pa0, pa1, pa2, pa3); pv_one<2>(o[2], vb, pa0, pa1, pa2, pa3); pv_one<3>(o[3], vb, pa0, pa1, pa2, pa3);
}

__device__ __forceinline__ void qkt_fin(f32x16& n0, f32x16& n1, const bf16_t* Ks, const bf16x8* qr, const f32x16& negm, int r32, int hi,
                                        f32x16& P0, f32x16& P1, float alpha, float& l_reg, bf16x8& pa0, bf16x8& pa1, bf16x8& pa2, bf16x8& pa3) {
  float psa = 0.f, psb = 0.f; u32x4 wa, wb, wc, wd;
#define QF_CHUNK(g) do { P1[g] = __builtin_amdgcn_exp2f(P1[g]); psa += P0[g]; if ((g) > 0) psb += P1[(g) > 0 ? (g) - 1 : 0];                                   \
    if ((g) & 1) { const unsigned w_ = cvtpk(P0[(g) - ((g) & 1)], P0[g]); if ((g) < 8) wa[((g) >> 1) & 3] = w_; else wb[((g) >> 1) & 3] = w_; }                    \
    if (((g) & 1) && (g) >= 3) { const unsigned w_ = cvtpk(P1[(g) >= 3 ? (g) - 3 : 0], P1[(g) >= 3 ? (g) - 2 : 0]); if ((g) < 11) wc[(((g) - 3) >> 1) & 3] = w_; else wd[(((g) - 3) >> 1) & 3] = w_; } \
    asm volatile("" : "+v"(P1), "+v"(psa), "+v"(psb)); } while (0)
#pragma unroll
  for (int d0 = 0; d0 < 8; ++d0) { int cb = (d0 * 16 + hi * 8) * 2;
    bf16x8 b0 = *reinterpret_cast<const bf16x8*>((const char*)Ks + KSWZ(r32, cb));
    bf16x8 b1 = *reinterpret_cast<const bf16x8*>((const char*)Ks + KSWZ(32 + r32, cb));
    SBAR(); if (d0 == 0) n0 = __builtin_amdgcn_mfma_f32_32x32x16_bf16(b0, qr[0], negm, 0, 0, 0); else n0 = __builtin_amdgcn_mfma_f32_32x32x16_bf16(b0, qr[d0], n0, 0, 0, 0);
    SBAR(); QF_CHUNK(2 * d0); SBAR();
    if (d0 == 0) n1 = __builtin_amdgcn_mfma_f32_32x32x16_bf16(b1, qr[0], negm, 0, 0, 0); else n1 = __builtin_amdgcn_mfma_f32_32x32x16_bf16(b1, qr[d0], n1, 0, 0, 0);
    SBAR(); QF_CHUNK(2 * d0 + 1); SBAR(); }
#undef QF_CHUNK
  psb += P1[15]; wd[3] = cvtpk(P1[14], P1[15]);
  l_reg = l_reg * alpha + (psa + psb);
  pa0 = *reinterpret_cast<bf16x8*>(&wa); pa1 = *reinterpret_cast<bf16x8*>(&wb); pa2 = *reinterpret_cast<bf16x8*>(&wc); pa3 = *reinterpret_cast<bf16x8*>(&wd);
}

struct VF8 { s16x4 l0, h0, l1, h1, l2, h2, l3, h3; };
template <int D0> __device__ __forceinline__ void vf8_read(VF8& f, int vb) {
  f.l0 = tr_read<v_rd_off(D0, 0, 0)>(vb); f.h0 = tr_read<v_rd_off(D0, 0, 1)>(vb); f.l1 = tr_read<v_rd_off(D0, 1, 0)>(vb); f.h1 = tr_read<v_rd_off(D0, 1, 1)>(vb);
  f.l2 = tr_read<v_rd_off(D0, 2, 0)>(vb); f.h2 = tr_read<v_rd_off(D0, 2, 1)>(vb); f.l3 = tr_read<v_rd_off(D0, 3, 0)>(vb); f.h3 = tr_read<v_rd_off(D0, 3, 1)>(vb);
}
#define PKV(L, H) (bf16x8){L[0], L[1], L[2], L[3], H[0], H[1], H[2], H[3]}
#define PVE_M(OD, PA, L, H, IDX) do { OD = __builtin_amdgcn_mfma_f32_32x32x16_bf16(PA, PKV(L, H), OD, 0, 0, 0); SBAR(); p[IDX] = __builtin_amdgcn_exp2f(p[IDX]); asm volatile("" : "+v"(p)); SBAR(); } while (0)
__device__ __forceinline__ void pv_exp(f32x16* o, int vb, bf16x8 pa0, bf16x8 pa1, bf16x8 pa2, bf16x8 pa3, f32x16& p) {
  VF8 fa, fb;
  vf8_read<0>(fa, vb); asm volatile("s_waitcnt lgkmcnt(0)" ::: "memory"); SBAR();
  PVE_M(o[0], pa0, fa.l0, fa.h0, 0); PVE_M(o[0], pa1, fa.l1, fa.h1, 1); vf8_read<1>(fb, vb); SBAR(); PVE_M(o[0], pa2, fa.l2, fa.h2, 2); PVE_M(o[0], pa3, fa.l3, fa.h3, 3);
  asm volatile("s_waitcnt lgkmcnt(0)" ::: "memory"); SBAR();
  PVE_M(o[1], pa0, fb.l0, fb.h0, 4); PVE_M(o[1], pa1, fb.l1, fb.h1, 5); vf8_read<2>(fa, vb); SBAR(); PVE_M(o[1], pa2, fb.l2, fb.h2, 6); PVE_M(o[1], pa3, fb.l3, fb.h3, 7);
  asm volatile("s_waitcnt lgkmcnt(0)" ::: "memory"); SBAR();
  PVE_M(o[2], pa0, fa.l0, fa.h0, 8); PVE_M(o[2], pa1, fa.l1, fa.h1, 9); vf8_read<3>(fb, vb); SBAR(); PVE_M(o[2], pa2, fa.l2, fa.h2, 10); PVE_M(o[2], pa3, fa.l3, fa.h3, 11);
  asm volatile("s_waitcnt lgkmcnt(0)" ::: "memory"); SBAR();
  PVE_M(o[3], pa0, fb.l0, fb.h0, 12); PVE_M(o[3], pa1, fb.l1, fb.h1, 13); PVE_M(o[3], pa2, fb.l2, fb.h2, 14); PVE_M(o[3], pa3, fb.l3, fb.h3, 15);
}
#undef PVE_M
#undef PKV

__device__ __forceinline__ void attn_item(const bf16_t* __restrict__ Qb, const bf16_t* __restrict__ Kh, const bf16_t* __restrict__ Vh, const bf16_t* __restrict__ Zb,
                                          bf16_t* __restrict__ Ob, int seq, char* lds, const int wid_s, const float* __restrict__ qg, const int qpos0, const float kmaxg) {
  int tid_ = MYTID(wid_s); asm volatile("" : "+v"(tid_)); const int tid = tid_, wid = tid >> 6, lane = tid & 63, r32 = lane & 31, hi = lane >> 5;
  constexpr int SLOT = 32768, KOFF = 16384, WSOFF = 3 * SLOT;
  float* ws = (float*)(lds + WSOFF) + wid * 64; float* al_l = ws + 32;
  float m_reg = 0.f, l_reg = 0; f32x16 o[4] = {}; bf16x8 qr[8]; f32x16 negm = f32x16{}; asm volatile("" : "+v"(negm));
  const bf16_t* Qw = Qb + (long)(wid * QBLK + r32) * LDQ + hi * 8;
  float qn2 = 0.f;
  {
    u32x4 qw[8];
#pragma unroll
    for (int d0 = 0; d0 < 8; ++d0) qw[d0] = *reinterpret_cast<const u32x4*>(Qw + d0 * 16);
    float ss = 0.f;
#pragma unroll
    for (int d0 = 0; d0 < 8; ++d0) { const float a0 = bflo(qw[d0].x), a1 = bfhi(qw[d0].x), a2 = bflo(qw[d0].y), a3 = bfhi(qw[d0].y), a4 = bflo(qw[d0].z), a5 = bfhi(qw[d0].z), a6 = bflo(qw[d0].w), a7 = bfhi(qw[d0].w);
      ss += (a0 * a0 + a1 * a1) + (a2 * a2 + a3 * a3) + (a4 * a4 + a5 * a5) + (a6 * a6 + a7 * a7); }
    { auto rr = __builtin_amdgcn_permlane32_swap(__float_as_uint(ss), __float_as_uint(ss), false, false); ss = __uint_as_float(rr[0]) + __uint_as_float(rr[1]); }
    const float rstd = __builtin_amdgcn_rsqf(ss * (1.0f / 128.0f) + NORM_EPS) * (SCALE * 1.4426950408889634f);
    const int hq = lane_id_asm() >> 5;
    const int spos = qpos0 + wid * QBLK + r32; const float prow = (float)(spos >> 6), pcol = (float)(spos & 63);
#pragma unroll
    for (int bb = 0; bb < 4; ++bb) { const int d1 = (bb & 1) + 4 * (bb >> 1), d2 = d1 + 2;
      const float pos = (bb < 2) ? prow : pcol; const float* g1p = qg + d1 * 16 + hq * 8; const float* g2p = qg + d2 * 16 + hq * 8;
      const f32x4 g1a = *(const f32x4*)g1p, g1b = *(const f32x4*)(g1p + 4), g2a = *(const f32x4*)g2p, g2b = *(const f32x4*)(g2p + 4);
      float o1[8], o2[8];
#pragma unroll
      for (int e = 0; e < 8; ++e) { const unsigned w1 = (e < 2) ? qw[d1].x : (e < 4) ? qw[d1].y : (e < 6) ? qw[d1].z : qw[d1].w, w2 = (e < 2) ? qw[d2].x : (e < 4) ? qw[d2].y : (e < 6) ? qw[d2].z : qw[d2].w;
        const float x1 = (e & 1) ? bfhi(w1) : bflo(w1), x2 = (e & 1) ? bfhi(w2) : bflo(w2); const float ga = (e < 4) ? g1a[e & 3] : g1b[e & 3], gb = (e < 4) ? g2a[e & 3] : g2b[e & 3];
        const int fi = (d1 & 1) * 16 + hq * 8 + e; float rev = pos * (__builtin_amdgcn_exp2f(-(float)fi * (13.287712379549449f / 32.0f)) * 0.15915494309189535f); rev -= floorf(rev);
        const float sn = sin_rev(rev), cs = cos_rev(rev), y1 = x1 * rstd * ga, y2 = x2 * rstd * gb; o1[e] = y1 * cs - y2 * sn; o2[e] = y2 * cs + y1 * sn; }
#pragma unroll
      for (int e = 0; e < 8; ++e) qn2 += o1[e] * o1[e] + o2[e] * o2[e];
      u32x4 p1 = {cvtpk(o1[0], o1[1]), cvtpk(o1[2], o1[3]), cvtpk(o1[4], o1[5]), cvtpk(o1[6], o1[7])}, p2 = {cvtpk(o2[0], o2[1]), cvtpk(o2[2], o2[3]), cvtpk(o2[4], o2[5]), cvtpk(o2[6], o2[7])};
      qr[d1] = *reinterpret_cast<bf16x8*>(&p1); qr[d2] = *reinterpret_cast<bf16x8*>(&p2); }
  }
  const int sr = tid >> 4, sc = (tid & 15) * 8, vst0 = v_st_nat(sr, sc), vst1 = v_st_nat(32 + sr, sc), kst0 = KOFF + KSWZ(sr, sc * 2), kst1 = KOFF + KSWZ(32 + sr, sc * 2);
  const int vb0 = (int)(uintptr_t)lds + v_rd_base(lane);
  struct { bf16x8 vs0, vs1, ks0, ks1; } sr_;
#define SLOAD(k0) do { sr_.vs0 = *(const bf16x8*)(&Vh[(long)((k0) + sr) * LDK + sc]); sr_.vs1 = *(const bf16x8*)(&Vh[(long)((k0) + 32 + sr) * LDK + sc]); \
    sr_.ks0 = *(const bf16x8*)(&Kh[(long)((k0) + sr) * LDK + sc]); sr_.ks1 = *(const bf16x8*)(&Kh[(long)((k0) + 32 + sr) * LDK + sc]); } while (0)
#define SWRITE(so) do { *(bf16x8*)(lds + (so) + vst0) = sr_.vs0; *(bf16x8*)(lds + (so) + vst1) = sr_.vs1;          \
    *(bf16x8*)(lds + (so) + kst0) = sr_.ks0; *(bf16x8*)(lds + (so) + kst1) = sr_.ks1; } while (0)
#define SWAIT() asm volatile("s_waitcnt vmcnt(0)" ::: "memory")
#define RESC(a) do { if (__any((a) < 1.f)) { if (hi == 0) al_l[r32] = (a); asm volatile("s_waitcnt lgkmcnt(0)" ::: "memory"); \
    _Pragma("unroll") for (int d = 0; d < 4; ++d) _Pragma("unroll") for (int r = 0; r < 16; ++r) o[d][r] *= al_l[crow(r, hi)]; } } while (0)
#define ROT() do { const int t_ = s_prev; s_prev = s_cur; s_cur = s_next; s_next = t_; } while (0)
  f32x16 pA0, pA1, pB0, pB1; float alA, alB; bf16x8 pa0, pa1, pa2, pa3; const int NT = seq / KVBLK;
  int s_prev = 0, s_cur = SLOT, s_next = 2 * SLOT;
  SLOAD(0); SWAIT(); SWRITE(0); __syncthreads();
  SLOAD(KVBLK);
  qkt(pA0, pA1, (const bf16_t*)(lds + KOFF), qr, negm, r32, hi); partialSM<true>(pA0, pA1, m_reg, negm, alA);
  { auto rr = __builtin_amdgcn_permlane32_swap(__float_as_uint(qn2), __float_as_uint(qn2), false, false); qn2 = __uint_as_float(rr[0]) + __uint_as_float(rr[1]); }
  const bool track = !__all(__builtin_sqrtf(qn2) * kmaxg - m_reg <= 90.f);
  SWAIT(); SWRITE(SLOT); __syncthreads();
  for (int j = 1; j + 1 < NT; j += 2) {
    SBAR(); SLOAD((j + 1) * KVBLK); SBAR();
    qkt_fin(pB0, pB1, (const bf16_t*)(lds + s_cur + KOFF), qr, negm, r32, hi, pA0, pA1, alA, l_reg, pa0, pa1, pa2, pa3); SBAR();
    partialSM<false, false>(pB0, pB1, m_reg, negm, alB, track); SBAR(); pv_exp(o, vb0 + s_prev, pa0, pa1, pa2, pa3, pB0);
    SWAIT(); SWRITE(s_next);
    RESC(alB); __syncthreads(); ROT();
    SBAR(); SLOAD((j + 2) * KVBLK); SBAR();
    qkt_fin(pA0, pA1, (const bf16_t*)(lds + s_cur + KOFF), qr, negm, r32, hi, pB0, pB1, alB, l_reg, pa0, pa1, pa2, pa3); SBAR();
    partialSM<false, false>(pA0, pA1, m_reg, negm, alA, track); SBAR(); pv_exp(o, vb0 + s_prev, pa0, pa1, pa2, pa3, pA0);
    SWAIT(); SWRITE(s_next);
    RESC(alA); __syncthreads(); ROT();
  }
  SBAR(); qkt_fin(pB0, pB1, (const bf16_t*)(lds + s_cur + KOFF), qr, negm, r32, hi, pA0, pA1, alA, l_reg, pa0, pa1, pa2, pa3); SBAR();
  partialSM<false, false>(pB0, pB1, m_reg, negm, alB, track); SBAR(); pv_exp(o, vb0 + s_prev, pa0, pa1, pa2, pa3, pB0);
  RESC(alB);
  finishSM(pB0, pB1, alB, l_reg, pa0, pa1, pa2, pa3); SBAR();
  pv_d0(o, vb0 + s_cur, pa0, pa1, pa2, pa3);
  __syncthreads();
  const int lane_e = lane_id_asm(), r32e = lane_e & 31, hie = lane_e >> 5;
  float* li_e = (float*)(lds + 3 * 32768) + wid_s * 64;
  { auto rr = __builtin_amdgcn_permlane32_swap(__float_as_uint(l_reg), __float_as_uint(l_reg), false, false); l_reg = __uint_as_float(rr[0]) + __uint_as_float(rr[1]); }
  if (hie == 0) li_e[r32e] = l_reg; asm volatile("s_waitcnt lgkmcnt(0)" ::: "memory");
  float rli[16];
#pragma unroll
  for (int r = 0; r < 16; ++r) rli[r] = __builtin_amdgcn_rcpf(li_e[crow(r, hie)]);
  bf16_t* Ow = Ob + (long)(wid_s * QBLK) * LDAF; const bf16_t* Zw = Zb + (long)(wid_s * QBLK) * LDP;
  bf16_t* stg = (bf16_t*)lds + wid_s * 4096;
#pragma unroll
  for (int r = 0; r < 16; ++r) { const int orow = crow(r, hie);
#pragma unroll
    for (int d0 = 0; d0 < 4; ++d0) stg[orow * 128 + d0 * 32 + r32e] = f2bf(o[d0][r] * rli[r]); }
  asm volatile("s_waitcnt lgkmcnt(0)" ::: "memory");
#pragma unroll
  for (int i = 0; i < 8; ++i) { const int row = i * 4 + (lane_e >> 4), ch = lane_e & 15;
    const u32x4 ov = *(const u32x4*)(stg + row * 128 + ch * 8); const u32x4 zv = *(const u32x4*)(Zw + (long)row * LDP + ch * 8);
    u32x4 w; w.x = cvtpk(bflo(ov.x) * bflo(zv.x), bfhi(ov.x) * bfhi(zv.x)); w.y = cvtpk(bflo(ov.y) * bflo(zv.y), bfhi(ov.y) * bfhi(zv.y));
    w.z = cvtpk(bflo(ov.z) * bflo(zv.z), bfhi(ov.z) * bfhi(zv.z)); w.w = cvtpk(bflo(ov.w) * bflo(zv.w), bfhi(ov.w) * bfhi(zv.w));
    *(u32x4*)(Ow + (long)row * LDAF + ch * 8) = w; }
  asm volatile("s_waitcnt lgkmcnt(0)" ::: "memory");
#undef ROT
#undef SLOAD
#undef SWRITE
#undef SWAIT
#undef RESC
}

template <int PASS>
__device__ __forceinline__ void fft_phase(unsigned char* wsb, char* lds, int G, int c, const int wid_s) {
  bf16_t* P1 = (bf16_t*)(wsb + WS_P1); bf16_t* AF = (bf16_t*)(wsb + WS_AF);
  const bf16_t* TAB = (const bf16_t*)(wsb + WS_TAB) + (PASS == 1 ? 0 : 256 * 256);
  int tid_ = MYTID(wid_s); asm volatile("" : "+v"(tid_)); const int tid = tid_, wid = tid >> 6, lane = tid & 63, r32 = lane & 31, hi = lane >> 5;
  const int wm = (PASS == 1) ? wid : (wid & 3), wn = (PASS == 1) ? 0 : (wid >> 2);
  bf16x8 pa[4][4];
#pragma unroll
  for (int kt = 0; kt < 4; ++kt)
#pragma unroll
    for (int ks = 0; ks < 4; ++ks) pa[kt][ks] = *(const bf16x8*)(TAB + (size_t)(32 * wm + r32) * 256 + 64 * kt + 16 * ks + 8 * hi);
  const int sr = tid >> 4, sc = (tid & 15) * 8, vst0 = v_st(sr, sc), vst1 = v_st(32 + sr, sc);
  const int vb0 = (int)(uintptr_t)lds + v_rd_base(lane) + wn * 1024;
  bf16x8 st[8];
#define FFT_LOAD(IT) do { const int g_ = (IT) & 3, idx_ = ((IT) >> 2) & 127, b_ = (IT) >> 9; const long rb_ = (long)b_ * SEQ + (PASS == 1 ? idx_ : idx_ * 128), rs_ = (PASS == 1) ? 128 : 1; \
    _Pragma("unroll") for (int kt = 0; kt < 4; ++kt) { const bf16_t* src = P1 + (kt < 2 ? C_ZR : C_ZI) + g_ * 128 + sc; const long row = rb_ + (long)(64 * (kt & 1) + sr) * rs_; \
      st[2 * kt] = *(const bf16x8*)(src + row * LDP); st[2 * kt + 1] = *(const bf16x8*)(src + (row + 32 * rs_) * LDP); } } while (0)
  if (c < 1024) FFT_LOAD(c);
  for (int it = c; it < 1024; it += G) {
    const int g = it & 3, idx = (it >> 2) & 127, b = it >> 9;
    __syncthreads();
#pragma unroll
    for (int kt = 0; kt < 4; ++kt) { *(bf16x8*)(lds + kt * 16384 + vst0) = st[2 * kt]; *(bf16x8*)(lds + kt * 16384 + vst1) = st[2 * kt + 1]; }
    __syncthreads();
    if (it + G < 1024) FFT_LOAD(it + G);
    if constexpr (PASS == 1) {
      f32x16 o[4] = {};
#pragma unroll
      for (int kt = 0; kt < 4; ++kt) pv_d0(o, vb0 + kt * 16384, pa[kt][0], pa[kt][1], pa[kt][2], pa[kt][3]);
      bf16_t* stg = (bf16_t*)(lds + 65536) + wid * 4096;
#pragma unroll
      for (int r = 0; r < 8; ++r) { const int k1l = crow(r, hi), k1 = 16 * wid + k1l; const float rev = (float)((k1 * idx) & 16383) * (1.0f / 16384.0f);
        const float sn = sin_rev(rev), cs = cos_rev(rev);
#pragma unroll
        for (int d0 = 0; d0 < 4; ++d0) { const float re = o[d0][r], im = o[d0][r + 8];
          stg[k1l * 128 + d0 * 32 + r32] = f2bf(re * cs + im * sn); stg[2048 + k1l * 128 + d0 * 32 + r32] = f2bf(im * cs - re * sn); } }
      asm volatile("s_waitcnt lgkmcnt(0)" ::: "memory");
#pragma unroll
      for (int i = 0; i < 8; ++i) { const int q = i * 64 + lane, part = q >> 8, k1l = (q >> 4) & 15, ch = q & 15;
        const u32x4 v = *(const u32x4*)(stg + part * 2048 + k1l * 128 + ch * 8);
        *(u32x4*)(P1 + ((long)b * SEQ + 128 * (16 * wid + k1l) + idx) * LDP + (part ? C_ZI : C_ZR) + g * 128 + ch * 8) = v; }
      asm volatile("s_waitcnt lgkmcnt(0)" ::: "memory");
    } else {
      f32x16 o[2] = {};
#pragma unroll
      for (int kt = 0; kt < 4; ++kt) { pv_one<0>(o[0], vb0 + kt * 16384, pa[kt][0], pa[kt][1], pa[kt][2], pa[kt][3]); pv_one<1>(o[1], vb0 + kt * 16384, pa[kt][0], pa[kt][1], pa[kt][2], pa[kt][3]); }
      constexpr float FS = 6.9053396600248786e-4f;
      float* stg = (float*)(lds + 65536) + wid * 2048;
#pragma unroll
      for (int r = 0; r < 16; ++r) { const int k2l = crow(r, hi);
#pragma unroll
        for (int d0 = 0; d0 < 2; ++d0) stg[k2l * 64 + d0 * 32 + r32] = o[d0][r] * FS; }
      asm volatile("s_waitcnt lgkmcnt(0)" ::: "memory");
#pragma unroll
      for (int i = 0; i < 4; ++i) { const int q = i * 64 + lane, k2l = q >> 3, ch = q & 7; const long row = (long)b * SEQ + idx + 128 * (32 * wm + k2l); const int col = g * 128 + wn * 64 + ch * 8;
        const f32x4 v0 = *(const f32x4*)(stg + k2l * 64 + ch * 8), v1 = *(const f32x4*)(stg + k2l * 64 + ch * 8 + 4); const u32x4 zv = *(const u32x4*)(P1 + row * LDP + C_ZF + col);
        u32x4 w; w.x = cvtpk(v0[0] * bflo(zv.x), v0[1] * bfhi(zv.x)); w.y = cvtpk(v0[2] * bflo(zv.y), v0[3] * bfhi(zv.y)); w.z = cvtpk(v1[0] * bflo(zv.z), v1[1] * bfhi(zv.z)); w.w = cvtpk(v1[2] * bflo(zv.w), v1[3] * bfhi(zv.w));
        *(u32x4*)(AF + row * LDAF + 1024 + col) = w; }
      asm volatile("s_waitcnt lgkmcnt(0)" ::: "memory");
    }
  }
#undef FFT_LOAD
  __syncthreads();
}
}

__device__ __forceinline__ void qk_fix(unsigned char* wsb, const float* qg, const float* kg, int G, int c, const int wid_s) {
  bf16_t* P1 = (bf16_t*)(wsb + WS_P1);
  int tid_ = MYTID(wid_s); asm volatile("" : "+v"(tid_)); const int tid = tid_, wid = tid >> 6, lane = tid & 63, sub = lane & 15, j = sub & 7, part = sub >> 3, grp = lane >> 4;
  const int e0 = part * 64 + 4 * j;
  const f32x4 gq1 = *(const f32x4*)(qg + e0), gq2 = *(const f32x4*)(qg + e0 + 32), gk1 = *(const f32x4*)(kg + e0), gk2 = *(const f32x4*)(kg + e0 + 32);
  float inv[4];
#pragma unroll
  for (int e = 0; e < 4; ++e) inv[e] = __builtin_amdgcn_exp2f(-(float)(4 * j + e) * (13.287712379549449f / 32.0f)) * 0.15915494309189535f;
  const long NT = (long)MROWS * 2, step = (long)G * 8 * 4;
  for (long t = ((long)wid * G + c) * 4 + grp; t < NT; t += step) {
    const int row = (int)(t >> 1), hh = 8 + (int)(t & 1);
    bf16_t* p = P1 + (long)row * LDP + hh * 128 + e0;
    const u32x2 a = *(const u32x2*)p, bq = *(const u32x2*)(p + 32);
    float x1[4] = {bflo(a.x), bfhi(a.x), bflo(a.y), bfhi(a.y)}, x2[4] = {bflo(bq.x), bfhi(bq.x), bflo(bq.y), bfhi(bq.y)};
    float ss = 0.f;
#pragma unroll
    for (int e = 0; e < 4; ++e) ss += x1[e] * x1[e] + x2[e] * x2[e];
    ss += __shfl_xor(ss, 1); ss += __shfl_xor(ss, 2); ss += __shfl_xor(ss, 4); ss += __shfl_xor(ss, 8);
    const float rstd = __builtin_amdgcn_rsqf(ss * (1.0f / 128.0f) + NORM_EPS);
    const f32x4 g1 = hh < 8 ? gq1 : gk1, g2 = hh < 8 ? gq2 : gk2;
    const int s = row & (SEQ - 1); const float pos = (float)(part == 0 ? (s >> 6) : (s & 63));
    float o1[4], o2[4];
#pragma unroll
    for (int e = 0; e < 4; ++e) { float rev = pos * inv[e]; rev -= floorf(rev); const float sn = sin_rev(rev), cs = cos_rev(rev);
      const float y1 = x1[e] * rstd * g1[e], y2 = x2[e] * rstd * g2[e]; o1[e] = y1 * cs - y2 * sn; o2[e] = y2 * cs + y1 * sn; }
    u32x2 w1, w2; w1.x = cvtpk(o1[0], o1[1]); w1.y = cvtpk(o1[2], o1[3]); w2.x = cvtpk(o2[0], o2[1]); w2.y = cvtpk(o2[2], o2[3]);
    *(u32x2*)p = w1; *(u32x2*)(p + 32) = w2;
  }
}

template <class F>
__device__ __forceinline__ void tr_item(F val, bf16_t* dst  , int ldt, LAS float* scr, int lane) {
#pragma unroll 4
  for (int i = 0; i < 32; ++i) { const int kk = 2 * i + (lane >> 5); scr[kk * 33 + (lane & 31)] = val(kk, lane & 31); }
  LDS_WAIT(); asm volatile("" ::: "memory");
  const int cc = lane & 7;
#pragma unroll
  for (int jj = 0; jj < 4; ++jj) { const int n = (lane >> 3) + 8 * jj; const LAS float* s = scr + (8 * cc) * 33 + n;
    u32x4 o; o.x = cvtpk(s[0 * 33], s[1 * 33]); o.y = cvtpk(s[2 * 33], s[3 * 33]); o.z = cvtpk(s[4 * 33], s[5 * 33]); o.w = cvtpk(s[6 * 33], s[7 * 33]);
    *(u32x4*)(dst + (size_t)n * ldt + 8 * cc) = o; }
  LDS_WAIT(); asm volatile("" ::: "memory");
}
template <class F>
__device__ __forceinline__ void tr_item16(F val, bf16_t* dst, int ldt, LAS float* scr, int lane) {
#pragma unroll
  for (int i = 0; i < 8; ++i) { const int kk = 2 * i + (lane >> 5); scr[kk * 33 + (lane & 31)] = val(kk, lane & 31); }
  LDS_WAIT(); asm volatile("" ::: "memory");
  { const int n = lane >> 1, cc = lane & 1; const LAS float* s = scr + (8 * cc) * 33 + n;
    u32x4 o; o.x = cvtpk(s[0 * 33], s[1 * 33]); o.y = cvtpk(s[2 * 33], s[3 * 33]); o.z = cvtpk(s[4 * 33], s[5 * 33]); o.w = cvtpk(s[6 * 33], s[7 * 33]);
    *(u32x4*)(dst + (size_t)n * ldt + 8 * cc) = o; }
  LDS_WAIT(); asm volatile("" ::: "memory");
}
struct Args { const float* in[10]; float* out; unsigned char* ws; };

__device__ __forceinline__ void p0_prologue(const Args& a, LAS unsigned char* ldsb, int G, int c, const int wid_s) {
  int tid_ = MYTID(wid_s); asm volatile("" : "+v"(tid_)); const int tid = tid_, wid = tid >> 6, lane = tid & 63;
  const float* x = a.in[0]; const float* norm_g = a.in[1]; const float* w_in = a.in[2]; const float* w_ap = a.in[5]; const float* w_fp = a.in[6]; const float* w_mg = a.in[7]; const float* w_out = a.in[9];
  bf16_t* W1T = (bf16_t*)(a.ws + WS_W1T); bf16_t* WCAT = (bf16_t*)(a.ws + WS_WCAT); bf16_t* WOUT = (bf16_t*)(a.ws + WS_WOUT); bf16_t* TAB = (bf16_t*)(a.ws + WS_TAB); bf16_t* H = (bf16_t*)(a.ws + WS_AF);
  LAS float* scr = (LAS float*)(ldsb + wid * 16384); LAS float* ct = scr + 2112; LAS float* st = ct + 128;
  ct[lane] = cos_rev((float)lane * (1.0f / 128.0f)); ct[lane + 64] = cos_rev((float)(lane + 64) * (1.0f / 128.0f));
  st[lane] = sin_rev((float)lane * (1.0f / 128.0f)); st[lane + 64] = sin_rev((float)(lane + 64) * (1.0f / 128.0f));
  LDS_WAIT(); asm volatile("" ::: "memory");
  const int gw = wid * G + c, NGW = 8 * G;
  constexpr int I0 = 2048, I1 = 1280, I2 = 256, I3 = 1024, I4 = 512, I5 = 256, I6 = 512, NITEMS = I0 + I1 + I2 + I3 + I4 + I5 + I6;
  for (int it = gw; it < NITEMS; it += NGW) {
    int r = it;
    if (r < I0) {
      const int kb = r >> 5, nb = r & 31, k0 = 16 * kb, n0 = 32 * nb, part = n0 >> 9, g = (n0 >> 7) & 3, cp0 = n0 & 127;
      const float* wrow = w_in + (size_t)k0 * 3584 + 2560 + g * 128; const LAS float* tb = part ? st : ct; const float sgn = part ? -1.f : 1.f;
      tr_item16([&](int kk, int nn) { const float* wr_ = wrow + (size_t)kk * 3584; const int cp = cp0 + nn; float s = 0.f;
#pragma unroll 8
          for (int cc = 0; cc < 128; ++cc) s += wr_[cc] * tb[(cc * cp) & 127];
          return s * sgn; }, W1T + (size_t)(C_ZR + n0) * 1024 + k0, 1024, scr, lane);
      continue; } r -= I0;
    if (r < I1) { const int kb = r / 80, nb = r % 80, k0 = 64 * kb, n0 = 32 * nb; const float* src = w_in + (size_t)k0 * 3584 + n0;
      tr_item([&](int kk, int nn) { return src[(size_t)kk * 3584 + nn]; }, W1T + (size_t)n0 * 1024 + k0, 1024, scr, lane); continue; } r -= I1;
    if (r < I2) { const int kb = r / 16, nb = r % 16, k0 = 64 * kb, n0 = 32 * nb; const float* src = w_in + (size_t)k0 * 3584 + 3072 + n0;
      tr_item([&](int kk, int nn) { return src[(size_t)kk * 3584 + nn]; }, W1T + (size_t)(C_ZF + n0) * 1024 + k0, 1024, scr, lane); continue; } r -= I2;
    if (r < I3) { const int kb = r / 64, nb = r % 64, k0 = 64 * kb, n0 = 32 * nb; const float* src = w_mg + (size_t)k0 * 2048 + n0;
      tr_item([&](int kk, int nn) { return src[(size_t)kk * 2048 + nn]; }, W1T + (size_t)(C_G + n0) * 1024 + k0, 1024, scr, lane); continue; } r -= I3;
    if (r < I4) { const int kb = r / 32, nb = r % 32, k0 = 64 * kb, n0 = 32 * nb; const float* src = w_ap + (size_t)k0 * 1024 + n0;
      tr_item([&](int kk, int nn) { return src[(size_t)kk * 1024 + nn]; }, WCAT + (size_t)n0 * 1536 + k0, 1536, scr, lane); continue; } r -= I4;
    if (r < I5) { const int kb = r / 32, nb = r % 32, k0 = 64 * kb, n0 = 32 * nb; const float* src = w_fp + (size_t)k0 * 1024 + n0;
      tr_item([&](int kk, int nn) { return src[(size_t)kk * 1024 + nn]; }, WCAT + (size_t)n0 * 1536 + 1024 + k0, 1536, scr, lane); continue; } r -= I5;
    { const int kb = r / 32, nb = r % 32, k0 = 64 * kb, n0 = 32 * nb; const float* src = w_out + (size_t)k0 * 1024 + n0;
      tr_item([&](int kk, int nn) { return src[(size_t)kk * 1024 + nn]; }, WOUT + (size_t)n0 * 1024 + k0, 1024, scr, lane); }
  }
  if (c == 0 && tid == 0) { const float* kg_ = a.in[4]; float gm = 0.f; for (int i = 0; i < 128; ++i) gm = fmaxf(gm, fabsf(kg_[i]));
    *(float*)(a.ws + WS_TAB + 262144) = gm * 11.313708499f * 1.02f; }
  for (int e = c * 512 + tid; e < 256 * 256 + 128 * 256; e += G * 512) {
    float v;
    if (e < 65536) { const int m = e >> 8, k = e & 255, w = m >> 5, i = m & 31, k1 = 16 * w + (i & 15), im = i >> 4, s1 = k & 127, pt = k >> 7;
      const float rev = (float)((k1 * s1) & 127) * (1.0f / 128.0f); const float cs = cos_rev(rev), sn = sin_rev(rev);
      v = (im == 0) ? (pt == 0 ? cs : sn) : (pt == 0 ? -sn : cs); }
    else { const int e2 = e - 65536, k2 = e2 >> 8, k = e2 & 255, s2 = k & 127, pt = k >> 7;
      const float rev = (float)((k2 * s2) & 127) * (1.0f / 128.0f); v = pt == 0 ? cos_rev(rev) : sin_rev(rev); }
    TAB[e] = f2bf(v);
  }
  f32x4 gn[4];
#pragma unroll
  for (int q = 0; q < 4; ++q) gn[q] = *(const f32x4*)(norm_g + 256 * q + 4 * lane);
  for (int m0 = gw * 4; m0 < MROWS; m0 += NGW * 4) {
    f32x4 v[4][4]; float ss[4];
#pragma unroll
    for (int rr = 0; rr < 4; ++rr) { const f32x4* xr = (const f32x4*)(x + (size_t)(m0 + rr) * DM) + lane;
#pragma unroll
      for (int q = 0; q < 4; ++q) v[rr][q] = xr[64 * q]; }
#pragma unroll
    for (int rr = 0; rr < 4; ++rr) { float s = 0.f;
#pragma unroll
      for (int q = 0; q < 4; ++q) s += (v[rr][q].x * v[rr][q].x + v[rr][q].y * v[rr][q].y) + (v[rr][q].z * v[rr][q].z + v[rr][q].w * v[rr][q].w);
      ss[rr] = s; }
#pragma unroll
    for (int o = 1; o < 64; o <<= 1) {
#pragma unroll
      for (int rr = 0; rr < 4; ++rr) ss[rr] += __shfl_xor(ss[rr], o); }
#pragma unroll
    for (int rr = 0; rr < 4; ++rr) { const float rstd = __builtin_amdgcn_rsqf(ss[rr] * (1.0f / DM) + NORM_EPS);
      u32x2* o8 = (u32x2*)(H + (size_t)(m0 + rr) * DM) + lane;
#pragma unroll
      for (int q = 0; q < 4; ++q) { u32x2 w; w.x = cvtpk(v[rr][q].x * rstd * gn[q].x, v[rr][q].y * rstd * gn[q].y); w.y = cvtpk(v[rr][q].z * rstd * gn[q].z, v[rr][q].w * rstd * gn[q].w); o8[64 * q] = w; } }
  }
}

#define XB_TMO      128
#define XB_XCNT(j)  (256  + 64 * (j))
#define XB_XSUB(j)  (1280 + 64 * (j))
#define XB_XGEN(j)  (2304 + 64 * (j))
#define XB_TOP      3328
#define XB_TOPGEN   3392
#define XCD_BAR_WORDS 3456
#define XB_SPIN_CAP (1u << 18)

__device__ __forceinline__ unsigned xb_ld(unsigned* p)              { return __hip_atomic_load(p, __ATOMIC_RELAXED, __HIP_MEMORY_SCOPE_AGENT); }
__device__ __forceinline__ unsigned xb_add(unsigned* p, unsigned v) { return __hip_atomic_fetch_add(p, v, __ATOMIC_RELAXED, __HIP_MEMORY_SCOPE_AGENT); }
__device__ __forceinline__ unsigned xb_xcc_id() { return (unsigned)__builtin_amdgcn_s_getreg((3 << 11) | 20) & 0xFu; }
#define XB_SPIN(cond, bar) do { unsigned _sp = 0; while (cond) { __builtin_amdgcn_s_sleep(1); \
    if ((++_sp & 255u) == 0u) { if (xb_ld(&(bar)[XB_TMO])) break; if (_sp > XB_SPIN_CAP) { atomicAdd(&(bar)[XB_TMO], 1u); break; } } } } while (0)

struct XcdBarrier {
    unsigned* bar; unsigned x;
    volatile LAS unsigned* st;
};

__device__ __forceinline__ XcdBarrier xcd_barrier_post(unsigned* bar, volatile LAS unsigned* st, const bool t0) {
    XcdBarrier b; b.bar = bar; b.x = xb_xcc_id(); b.st = st;
    if (t0) (void)xb_add(&bar[XB_XCNT(b.x)], 1u);
    return b;
}
__device__ __forceinline__ void xcd_barrier_complete(unsigned* bar, unsigned x, unsigned& nloc, unsigned& nx) {
    const unsigned G = gridDim.x * gridDim.y * gridDim.z;
    unsigned sum, cnt, mine, sp = 0u;
    for (;;) {
        sum = 0u; cnt = 0u; mine = 0u;
#pragma unroll
        for (unsigned j = 0; j < 16; ++j) { const unsigned c = xb_ld(&bar[XB_XCNT(j)]); sum += c; cnt += (c > 0u) ? 1u : 0u; mine = (j == x) ? c : mine; }
        if (sum == G) break;
        __builtin_amdgcn_s_sleep(1);
        if ((++sp & 255u) == 0u) { if (xb_ld(&bar[XB_TMO])) break; if (sp > XB_SPIN_CAP) { atomicAdd(&bar[XB_TMO], 1u); break; } }
    }
    nloc = mine > 0u ? mine : 1u; nx = cnt > 0u ? cnt : 1u;
}

__device__ __forceinline__ void xcd_barrier(const XcdBarrier& b, const bool t0) {
    asm volatile("s_waitcnt vmcnt(0)" ::: "memory");
    __syncthreads();
    if (t0) {
        unsigned* bar = b.bar;
        __builtin_amdgcn_s_waitcnt(0);
        unsigned nloc = b.st[0], nx = b.st[1];
        if (nloc == 0u) { xcd_barrier_complete(bar, b.x, nloc, nx); b.st[0] = nloc; b.st[1] = nx; }
        const unsigned old = xb_add(&bar[XB_XSUB(b.x)], 1u);
        const unsigned gen = old / nloc;
        if (old + 1u == (gen + 1u) * nloc) {
            __builtin_amdgcn_fence(__ATOMIC_RELEASE, "agent");
            asm volatile("s_waitcnt vmcnt(0)" ::: "memory");
            const unsigned og = xb_add(&bar[XB_TOP], 1u);
            const unsigned tg = og / nx;
            if (og + 1u == (tg + 1u) * nx) xb_add(&bar[XB_TOPGEN], 1u);
            else XB_SPIN(xb_ld(&bar[XB_TOPGEN]) == tg, bar);
            __builtin_amdgcn_fence(__ATOMIC_ACQUIRE, "agent");
            xb_add(&bar[XB_XGEN(b.x)], 1u);
            asm volatile("s_waitcnt vmcnt(0)" ::: "memory");
        } else {
            XB_SPIN(xb_ld(&bar[XB_XGEN(b.x)]) == gen, bar);
            __builtin_amdgcn_fence(__ATOMIC_ACQUIRE, "agent");
            asm volatile("s_waitcnt vmcnt(0)" ::: "memory");
        }
    }
    __syncthreads();
}

__global__ void __launch_bounds__(512, 2) fwd_megakernel(Args a) {
  extern __shared__ __attribute__((aligned(16))) unsigned char lds[];
  cg::grid_group grid = cg::this_grid();
  const int G = gridDim.x, c = blockIdx.x, wid_s = __builtin_amdgcn_readfirstlane((int)threadIdx.x >> 6);
  bf16_t* P1 = (bf16_t*)(a.ws + WS_P1); bf16_t* AF = (bf16_t*)(a.ws + WS_AF);
#ifndef PH
#define PH 255
#endif
  unsigned* BAR = (unsigned*)(a.ws + WS_CTL); volatile LAS unsigned* bst = (volatile LAS unsigned*)((LAS unsigned char*)lds + 147200);
  { const int l0 = lane_id_asm(); if (wid_s == 0 && l0 < 2) bst[l0] = 0u; }
  __syncthreads();
  const XcdBarrier xbar = xcd_barrier_post(BAR, bst, wid_s == 0 && lane_id_asm() == 0);
#define GRID_BAR() xcd_barrier(xbar, wid_s == 0 && lane_id_asm() == 0)
  if (a.out == nullptr) grid.sync();
  if (PH & 1) p0_prologue(a, (LAS unsigned char*)lds, G, c, wid_s);
  GRID_BAR();
  if (PH & 2) { pg8::Gemm g{(const bf16_t*)(a.ws + WS_AF), (const bf16_t*)(a.ws + WS_W1T), MROWS, LDP, DM, DM, DM}; pg8::StaticOrder S; S.init(MROWS, LDP, G, c);
    pg8::EpiG1 E{P1, a.in[8]};
    pg8::gemm_phase<pg8::EpiG1, pg8::StaticOrder, false, true>((LAS unsigned char*)lds, g, S, E, wid_s); }
  GRID_BAR();
  if (PH & 4) att::fft_phase<1>(a.ws, (char*)lds, G, c, wid_s);
  if (PH & 64) qk_fix(a.ws, a.in[3], a.in[4], G, c, wid_s);
  GRID_BAR();
  if (PH & 128) att::fft_phase<2>(a.ws, (char*)lds, G, c, wid_s);
  const float kmaxg = *(const float*)(a.ws + WS_TAB + 262144);
  if (PH & 8) for (int it = c; it < 1024; it += G) {
    const int xx = it & 7, rest = it >> 3, bk = xx >> 1, qb = (xx & 1) * 32 + (rest & 31), hq = rest >> 5, kvh = bk & 1, h = kvh * 4 + hq, b = bk >> 1;
    const long row0 = (long)b * SEQ + qb * 256;
    att::attn_item(P1 + row0 * LDP + C_Q + h * 128, P1 + (long)b * SEQ * LDP + C_K + kvh * 128, P1 + (long)b * SEQ * LDP + C_V + kvh * 128,
                   P1 + row0 * LDP + C_ZA + h * 128, AF + row0 * LDAF + h * 128, SEQ, (char*)lds, wid_s, a.in[3], qb * 256, kmaxg);
    __syncthreads();
  }
  GRID_BAR();
  if (PH & 16) { pg8::Gemm g{AF, (const bf16_t*)(a.ws + WS_WCAT), MROWS, DM, LDAF, LDAF, LDAF}; pg8::StaticOrder S; S.init(MROWS, DM, G, c);
    pg8::EpiG3 E{P1, P1 + C_MG};
    pg8::gemm_phase<pg8::EpiG3, pg8::StaticOrder, false, true>((LAS unsigned char*)lds, g, S, E, wid_s); }
  GRID_BAR();
  if (PH & 32) { pg8::Gemm g{P1 + C_MG, (const bf16_t*)(a.ws + WS_WOUT), MROWS, DM, DM, LDP, DM}; pg8::StaticOrder S; S.init(MROWS, DM, G, c);
    pg8::EpiG4 E{a.in[0], a.out};
    pg8::gemm_phase<pg8::EpiG4, pg8::StaticOrder, true, true>((LAS unsigned char*)lds, g, S, E, wid_s); }
}

extern "C" void kernel_launch(void* const* d_in, const int* in_sizes, int n_in, void* d_out, int out_size, void* d_ws, size_t ws_size, hipStream_t stream) {
  static int grid = 0;
  if (grid == 0) {
    if (n_in != 10 || in_sizes[0] != MROWS * DM || out_size != MROWS * DM || ws_size < WS_END) {
      fprintf(stderr, "kernel_launch: shape mismatch n_in %d in0 %d out %d ws %zu (need %zu)\n", n_in, n_in > 0 ? in_sizes[0] : -1, out_size, ws_size, (size_t)WS_END); grid = -1; return; }
    int dev = 0, cus = 0, per_cu = 0;
    hipGetDevice(&dev); hipDeviceGetAttribute(&cus, hipDeviceAttributeMultiprocessorCount, dev);
    if (hipFuncSetAttribute((const void*)fwd_megakernel, hipFuncAttributeMaxDynamicSharedMemorySize, LDS_BYTES) != hipSuccess) { fprintf(stderr, "kernel_launch: hipFuncSetAttribute failed\n"); grid = -1; return; }
    if (hipOccupancyMaxActiveBlocksPerMultiprocessor(&per_cu, (const void*)fwd_megakernel, 512, LDS_BYTES) != hipSuccess || per_cu < 1) { fprintf(stderr, "kernel_launch: occupancy query gave %d\n", per_cu); per_cu = 1; }
    (void)hipGetLastError();
    grid = cus * per_cu;
  }
  if (grid < 0) return;
  if (hipMemsetAsync((char*)d_ws + WS_CTL, 0, XCD_BAR_WORDS * 4, stream) != hipSuccess) { fprintf(stderr, "kernel_launch: hipMemsetAsync of the barrier words failed\n"); return; }
  Args a{};
  for (int i = 0; i < 10; ++i) a.in[i] = (const float*)d_in[i];
  a.out = (float*)d_out; a.ws = (unsigned char*)d_ws;
  void* args[] = {&a};
  hipError_t e = hipLaunchCooperativeKernel((const void*)fwd_megakernel, dim3(grid), dim3(512), args, LDS_BYTES, stream);
  if (e != hipSuccess) fprintf(stderr, "kernel_launch: cooperative launch failed: %s (grid %d)\n", hipGetErrorString(e), grid);
}
```

```cpp
#include <hip/hip_runtime.h>
#include <hip/hip_bf16.h>
#include <hip/hip_cooperative_groups.h>
#include <cstdio>
#include <cstdint>
#include <type_traits>
namespace cg = cooperative_groups;
namespace pg8 {
#define PG8_LAS __attribute__((address_space(3)))
typedef unsigned short bf16_t;
typedef short bf16x8 __attribute__((ext_vector_type(8)));
typedef float f32x4 __attribute__((ext_vector_type(4)));
typedef unsigned u32x4 __attribute__((ext_vector_type(4)));
constexpr int BM = 256, BK = 64, HALF = 128, HTB = HALF * BK * 2  , STAGE_BYTES = 8 * HTB, NXCD = 8, WGM = 8;

__host__ __device__ __forceinline__ int lds_byte(int r, int c) { const int st = (r >> 4) * 2 + (c >> 5), rr = r & 15, cc = c & 31, ob = rr * 64 + cc * 2; return st * 1024 + (ob ^ (((ob >> 9) & 1) << 5)); }
__host__ __device__ __forceinline__ void stage_rc(int b, int& R, int& C) { const int st = b / 1024, sb = b % 1024, swz = sb ^ (((sb >> 9) & 1) << 5); R = (st >> 1) * 16 + swz / 64; C = (st & 1) * 32 + (swz % 64) / 2; }
__host__ __device__ __forceinline__ int perm32(int rho) { const int n = rho >> 4, i = rho & 15; return 8 * (i >> 2) + 4 * n + (i & 3); }

struct Unit { int pm, pn; };
struct Gemm { const bf16_t* A; const bf16_t* Bt; int M, N, K, lda, ldb; };

struct StaticOrder {
    int nM, nN, nwg, G, c;
    __host__ __device__ void init(int M, int N, int G_, int c_) { nM = M / BM; nN = N / BM; nwg = nM * nN; G = G_; c = c_; }
    __host__ __device__ bool next(int i, Unit& u) const {
        const long L = (long)i * G + c; if (L >= nwg) return false;
        int wgid = (int)L; { const int q = nwg / NXCD, r = nwg % NXCD, xcd = wgid % NXCD, off = wgid / NXCD; wgid = (xcd < r ? xcd * (q + 1) : r * (q + 1) + (xcd - r) * q) + off; }
        const int nig = WGM * nN, gid = wgid / nig, fm = gid * WGM, gsz = (nM - fm) < WGM ? (nM - fm) : WGM;
        u.pm = fm + ((wgid % nig) % gsz); u.pn = (wgid % nig) / gsz; return true;
    }
    __device__ __forceinline__ void a_ready(const Unit&) const {}
    __device__ __forceinline__ void done(const Unit&) const {}
};

__device__ __forceinline__ unsigned cvt_pk_bf16(float lo, float hi) { unsigned r; asm volatile("v_cvt_pk_bf16_f32 %0, %1, %2" : "=v"(r) : "v"(lo), "v"(hi)); return r; }
template <class Epi, class Sched, bool ALIGN_EPI = false, bool SP2 = false>
__device__ __forceinline__ void gemm_phase(PG8_LAS unsigned char* lds, const Gemm g, const Sched& S, const Epi& E, const int wid_s) {
    int tid_; asm volatile("v_mbcnt_lo_u32_b32 %0, -1, 0\n\tv_mbcnt_hi_u32_b32 %0, -1, %0" : "=v"(tid_)); tid_ += wid_s * 64;
    const int tid = tid_, wid = __builtin_amdgcn_readfirstlane(tid >> 6), lane = tid & 63, wr = wid >> 2, wc = wid & 3, fr = lane & 15, fq = lane >> 4;
    const int K = g.K, nt = K / BK;
    unsigned voffA[2], voffB[2];
#pragma unroll
    for (int i = 0; i < 2; ++i) { int R, C; stage_rc(tid * 16 + i * 8192, R, C); const int Rb = Epi::PERM ? ((R & ~31) + perm32(R & 31)) : R;
        voffA[i] = (unsigned)(R * g.lda + C) * 2u; voffB[i] = (unsigned)(Rb * g.ldb + C) * 2u; }
    const size_t kstep = (size_t)(BK * 2);
    const size_t hstepA = (size_t)HALF * g.lda * 2, hstepB = (size_t)HALF * g.ldb * 2;
    const size_t tstepA = 2 * hstepA, tstepB = 2 * hstepB;
    const unsigned ldsw = (unsigned)wid * 1024u;
    const int aoff = lds_byte(wr * 64 + fr, fq * 8), boff = lds_byte(wc * 32 + fr, fq * 8);
#define PG8_SA(b, h) (((b) * 2 + (h)) * HTB)
#define PG8_SB(b, h) ((4 + (b) * 2 + (h)) * HTB)
#define PG8_STAGE(bufoff, gbase, voff) do { _Pragma("unroll") for (int _i = 0; _i < 2; ++_i) \
        __builtin_amdgcn_global_load_lds((const unsigned*)((const char*)(gbase) + (voff)[_i]), (PG8_LAS unsigned*)(lds + (bufoff) + ldsw + _i * 8192), 16, 0, 0); } while (0)
#define PG8_LDA(dst, b, h) do { _Pragma("unroll") for (int m = 0; m < 4; ++m) _Pragma("unroll") for (int k = 0; k < 2; ++k) dst[m][k] = *(const PG8_LAS bf16x8*)(lds + PG8_SA(b, h) + aoff + m * 2048 + k * 1024); } while (0)
#define PG8_LDB(dst, b, h) do { _Pragma("unroll") for (int n = 0; n < 2; ++n) _Pragma("unroll") for (int k = 0; k < 2; ++k) dst[n][k] = *(const PG8_LAS bf16x8*)(lds + PG8_SB(b, h) + boff + n * 2048 + k * 1024); } while (0)
#define PG8_MMA(ai, bj, At, Bt) do { __builtin_amdgcn_s_setprio(1); _Pragma("unroll") for (int m = 0; m < 4; ++m) _Pragma("unroll") for (int n = 0; n < 2; ++n) _Pragma("unroll") for (int k = 0; k < 2; ++k) \
        acc[ai][bj][m][n] = __builtin_amdgcn_mfma_f32_16x16x32_bf16(Bt[n][k], At[m][k], acc[ai][bj][m][n], 0, 0, 0); __builtin_amdgcn_s_setprio(0); } while (0)
#define PG8_WAIT_V(n) asm volatile("s_waitcnt vmcnt(" #n ")" ::: "memory")
#define PG8_WAIT_L(n) asm volatile("s_waitcnt lgkmcnt(" #n ")" ::: "memory")
#define PG8_BAR __builtin_amdgcn_s_barrier()
#define PG8_SCHED __builtin_amdgcn_sched_barrier(0)
    Unit cur, nxt; int ui = 0;
    if (!S.next(0, cur)) return;
    f32x4 acc[2][2][4][2];
#pragma unroll
    for (int a = 0; a < 2; ++a)
#pragma unroll
        for (int b = 0; b < 2; ++b)
#pragma unroll
            for (int m = 0; m < 4; ++m)
#pragma unroll
                for (int n = 0; n < 2; ++n) acc[a][b][m][n] = (f32x4){0.f, 0.f, 0.f, 0.f};
    bf16x8 At[4][2], B0[2][2], B1[2][2];
    const char* cA = (const char*)g.A + (size_t)cur.pm * tstepA; const char* cB = (const char*)g.Bt + (size_t)cur.pn * tstepB;
    S.a_ready(cur);
    if constexpr (SP2) {
        PG8_STAGE(PG8_SB(0, 0), cB, voffB); PG8_STAGE(PG8_SB(0, 1), cB + hstepB, voffB); PG8_STAGE(PG8_SA(0, 0), cA, voffA); PG8_STAGE(PG8_SA(0, 1), cA + hstepA, voffA);
        if (wr == 1) PG8_BAR;
        PG8_WAIT_V(2); PG8_BAR;
        PG8_STAGE(PG8_SB(1, 0), cB + kstep, voffB); PG8_STAGE(PG8_SA(1, 0), cA + kstep, voffA); PG8_STAGE(PG8_SB(1, 1), cB + hstepB + kstep, voffB);
        PG8_WAIT_V(6); PG8_BAR;
    } else {
        PG8_STAGE(PG8_SB(0, 0), cB, voffB); PG8_STAGE(PG8_SA(0, 0), cA, voffA); PG8_STAGE(PG8_SB(0, 1), cB + hstepB, voffB); PG8_STAGE(PG8_SA(0, 1), cA + hstepA, voffA);
        if (wr == 1) PG8_BAR;
        PG8_WAIT_V(4); PG8_BAR;
        PG8_STAGE(PG8_SB(1, 0), cB + kstep, voffB); PG8_STAGE(PG8_SA(1, 0), cA + kstep, voffA); PG8_STAGE(PG8_SB(1, 1), cB + hstepB + kstep, voffB);
        PG8_WAIT_V(6); PG8_BAR;
    }
    for (;;) {
        const bool has_next = S.next(ui + 1, nxt);
        const char* nA = has_next ? (const char*)g.A + (size_t)nxt.pm * tstepA : cA; const char* nB = has_next ? (const char*)g.Bt + (size_t)nxt.pn * tstepB : cB;
        for (int t = 0; t < nt; t += 2) {
            const bool last = (t == nt - 2);
            const char* a1 = cA + (size_t)(t + 1) * kstep;
            const char* a2 = last ? nA : cA + (size_t)(t + 2) * kstep; const char* b2 = last ? nB : cB + (size_t)(t + 2) * kstep;
            const char* a3 = a2 + kstep; const char* b3 = b2 + kstep;
            if (last && has_next) S.a_ready(nxt);
            if constexpr (Epi::HAS_MID) { if (t == Epi::MID_T) { asm volatile("" ::: "memory"); E.mid(acc, cur, wr, wc, fr, fq); asm volatile("" ::: "memory"); } }
            if constexpr (SP2) {
            PG8_LDB(B0, 0, 0); PG8_LDB(B1, 0, 1); PG8_SCHED; PG8_LDA(At, 0, 0); PG8_STAGE(PG8_SA(1, 1), a1 + hstepA, voffA);
            PG8_WAIT_V(8); PG8_WAIT_L(0); PG8_BAR; PG8_MMA(0, 0, At, B0); PG8_MMA(0, 1, At, B1); PG8_BAR; PG8_SCHED;
            PG8_LDA(At, 0, 1); PG8_STAGE(PG8_SB(0, 0), b2, voffB); PG8_STAGE(PG8_SB(0, 1), b2 + hstepB, voffB); PG8_STAGE(PG8_SA(0, 0), a2, voffA);
            PG8_WAIT_V(8); PG8_WAIT_L(0); PG8_BAR; PG8_MMA(1, 0, At, B0); PG8_MMA(1, 1, At, B1); PG8_BAR; PG8_SCHED;
            PG8_LDB(B0, 1, 0); PG8_LDB(B1, 1, 1); PG8_SCHED; PG8_LDA(At, 1, 0); PG8_STAGE(PG8_SA(0, 1), a2 + hstepA, voffA);
            PG8_WAIT_V(8); PG8_WAIT_L(0); PG8_BAR; PG8_MMA(0, 0, At, B0); PG8_MMA(0, 1, At, B1); PG8_BAR; PG8_SCHED;
            PG8_LDA(At, 1, 1); PG8_STAGE(PG8_SB(1, 0), b3, voffB); PG8_STAGE(PG8_SB(1, 1), b3 + hstepB, voffB); PG8_STAGE(PG8_SA(1, 0), a3, voffA);
            PG8_WAIT_V(8); PG8_WAIT_L(0); PG8_BAR; PG8_MMA(1, 0, At, B0); PG8_MMA(1, 1, At, B1); PG8_BAR; PG8_SCHED;
            } else {
            PG8_LDB(B0, 0, 0); PG8_SCHED; PG8_LDA(At, 0, 0); PG8_STAGE(PG8_SA(1, 1), a1 + hstepA, voffA);
            PG8_WAIT_L(8); PG8_BAR; PG8_WAIT_L(0); PG8_MMA(0, 0, At, B0); PG8_BAR; PG8_SCHED;
            PG8_LDB(B1, 0, 1); PG8_STAGE(PG8_SB(0, 0), b2, voffB);
            PG8_BAR; PG8_WAIT_L(0); PG8_MMA(0, 1, At, B1); PG8_BAR;
            PG8_LDA(At, 0, 1); PG8_STAGE(PG8_SA(0, 0), a2, voffA);
            PG8_BAR; PG8_WAIT_L(0); PG8_MMA(1, 0, At, B0); PG8_BAR; PG8_SCHED;
            PG8_STAGE(PG8_SB(0, 1), b2 + hstepB, voffB);
            PG8_WAIT_V(6); PG8_BAR; PG8_MMA(1, 1, At, B1); PG8_BAR;
            PG8_LDB(B0, 1, 0); PG8_SCHED; PG8_LDA(At, 1, 0); PG8_STAGE(PG8_SA(0, 1), a2 + hstepA, voffA);
            PG8_WAIT_L(8); PG8_BAR; PG8_WAIT_L(0); PG8_MMA(0, 0, At, B0); PG8_BAR; PG8_SCHED;
            PG8_LDB(B1, 1, 1); PG8_STAGE(PG8_SB(1, 0), b3, voffB);
            PG8_BAR; PG8_WAIT_L(0); PG8_MMA(0, 1, At, B1); PG8_BAR;
            PG8_LDA(At, 1, 1); PG8_STAGE(PG8_SA(1, 0), a3, voffA);
            PG8_BAR; PG8_WAIT_L(0); PG8_MMA(1, 0, At, B0); PG8_BAR; PG8_SCHED;
            PG8_STAGE(PG8_SB(1, 1), b3 + hstepB, voffB);
            PG8_WAIT_V(6); PG8_BAR; PG8_MMA(1, 1, At, B1); PG8_BAR;
            }
        }
        if constexpr (ALIGN_EPI) { if (wr == 0) PG8_BAR; }
        if constexpr (!Epi::AFTER_DRAIN) { E(acc, cur, wr, wc, fr, fq); S.done(cur); }
        if (!has_next) break;
#pragma unroll
        for (int a = 0; a < 2; ++a)
#pragma unroll
            for (int b = 0; b < 2; ++b)
#pragma unroll
                for (int m = 0; m < 4; ++m)
#pragma unroll
                    for (int n = 0; n < 2; ++n) acc[a][b][m][n] = (f32x4){0.f, 0.f, 0.f, 0.f};
        cur = nxt; cA = nA; cB = nB; ++ui;
        if constexpr (ALIGN_EPI) { if (wr == 1) PG8_BAR; }
    }
    PG8_WAIT_V(0);
    if constexpr (!ALIGN_EPI) { if (wr == 0) PG8_BAR; }
    PG8_BAR;
    if constexpr (Epi::AFTER_DRAIN) { E.fused(acc, cur, wr, wc, fr, fq, lds, wid, lane); S.done(cur); }
#undef PG8_SA
#undef PG8_SB
#undef PG8_STAGE
#undef PG8_LDA
#undef PG8_LDB
#undef PG8_MMA
#undef PG8_WAIT_V
#undef PG8_WAIT_L
#undef PG8_BAR
#undef PG8_SCHED
}
}

constexpr int BATCH = 2, SEQ = 16384, DM = 1024, MROWS = BATCH * SEQ;
constexpr int LDP = 6144;
constexpr int C_Q = 0, C_K = 1024, C_V = 1280, C_ZA = 1536, C_ZR = 2560, C_ZI = 3072, C_ZF = 3584, C_G = 4096;
constexpr int C_MG = 1536;
constexpr int LDAF = 1536;
constexpr size_t MiB = 1u << 20;
constexpr size_t WS_P1 = 0, WS_AF = 384 * MiB, WS_W1T = 480 * MiB, WS_WCAT = 492 * MiB, WS_WOUT = 495 * MiB, WS_TAB = 497 * MiB, WS_CTL = WS_TAB + 262144 + 4096  , WS_END = 498 * MiB;
constexpr int LDS_BYTES = 147456;
constexpr float NORM_EPS = 1e-6f;

typedef unsigned short bf16_t;
typedef short bf16x8 __attribute__((ext_vector_type(8)));
typedef short s16x4 __attribute__((ext_vector_type(4)));
typedef float f32x4 __attribute__((ext_vector_type(4)));
typedef float f32x16 __attribute__((ext_vector_type(16)));
typedef unsigned u32x4 __attribute__((ext_vector_type(4)));
typedef unsigned u32x2 __attribute__((ext_vector_type(2)));
#define LAS __attribute__((address_space(3)))
#define LDS_WAIT() asm volatile("s_waitcnt lgkmcnt(0)" ::: "memory")
#define SBAR() __builtin_amdgcn_sched_barrier(0)
__device__ __forceinline__ int lane_id_asm() { int r; asm volatile("v_mbcnt_lo_u32_b32 %0, -1, 0\n\tv_mbcnt_hi_u32_b32 %0, -1, %0" : "=v"(r)); return r; }
#define MYTID(w) ((w) * 64 + lane_id_asm())

__device__ __forceinline__ unsigned cvtpk(float lo, float hi) { unsigned r; asm volatile("v_cvt_pk_bf16_f32 %0, %1, %2" : "=v"(r) : "v"(lo), "v"(hi)); return r; }
__device__ __forceinline__ bf16_t f2bf(float f) { return (bf16_t)(cvtpk(f, f) & 0xffffu); }
__device__ __forceinline__ float bf2f(bf16_t h) { return __uint_as_float((unsigned)h << 16); }
__device__ __forceinline__ float bflo(unsigned w) { return __uint_as_float(w << 16); }
__device__ __forceinline__ float bfhi(unsigned w) { return __uint_as_float(w & 0xffff0000u); }
__device__ __forceinline__ float sigm(float v) { return __builtin_amdgcn_rcpf(1.0f + __builtin_amdgcn_exp2f(-1.4426950408889634f * v)); }
__device__ __forceinline__ float sin_rev(float rev) { return __builtin_amdgcn_sinf(rev); }
__device__ __forceinline__ float cos_rev(float rev) { return __builtin_amdgcn_cosf(rev); }

namespace pg8 {
struct EpiG1 {
    static constexpr bool PERM = true, AFTER_DRAIN = false, HAS_MID = false; static constexpr int MID_T = 0;
    bf16_t* O; const float* bias;
    __device__ __forceinline__ void mid(f32x4 (&)[2][2][4][2], const Unit&, int, int, int, int) const {}
    __device__ __forceinline__ void operator()(const f32x4 (&acc)[2][2][4][2], const Unit& u, int wr, int wc, int fr, int fq) const {
        const int pn = u.pn;
        const int mode = (pn >= 16) ? 2 : (((pn >= 6 && pn < 10) || pn >= 14) ? 1 : 0);
        const int row0 = u.pm * BM + wr * 64 + fr, col0 = pn * BM + wc * 32 + 8 * fq;
        f32x4 bv[2][2];
#pragma unroll
        for (int bj = 0; bj < 2; ++bj)
#pragma unroll
            for (int n = 0; n < 2; ++n) bv[bj][n] = (mode == 2) ? *(const f32x4*)(bias + (col0 - C_G) + bj * HALF + 4 * n) : (f32x4){0.f, 0.f, 0.f, 0.f};
#pragma unroll
        for (int ai = 0; ai < 2; ++ai)
#pragma unroll
            for (int m = 0; m < 4; ++m) { bf16_t* rowp = O + (size_t)(row0 + ai * HALF + m * 16) * LDP + col0;
#pragma unroll
                for (int bj = 0; bj < 2; ++bj) { f32x4 v0 = acc[ai][bj][m][0] + bv[bj][0], v1 = acc[ai][bj][m][1] + bv[bj][1];
                    if (mode == 1) {
#pragma unroll
                        for (int e = 0; e < 4; ++e) { v0[e] = v0[e] * sigm(v0[e]); v1[e] = v1[e] * sigm(v1[e]); } }
                    else if (mode == 2) {
#pragma unroll
                        for (int e = 0; e < 4; ++e) { v0[e] = sigm(v0[e]); v1[e] = sigm(v1[e]); } }
                    u32x4 w; w.x = cvt_pk_bf16(v0[0], v0[1]); w.y = cvt_pk_bf16(v0[2], v0[3]); w.z = cvt_pk_bf16(v1[0], v1[1]); w.w = cvt_pk_bf16(v1[2], v1[3]);
                    *(u32x4*)(rowp + bj * HALF) = w; } }
    }
};
struct EpiG3 {
    static constexpr bool PERM = true, AFTER_DRAIN = false, HAS_MID = true; static constexpr int MID_T = 16;
    const bf16_t* P; bf16_t* O;
    __device__ __forceinline__ void mid(f32x4 (&acc)[2][2][4][2], const Unit& u, int wr, int wc, int fr, int fq) const {
        const int row0 = u.pm * BM + wr * 64 + fr, col0 = u.pn * BM + wc * 32 + 8 * fq;
#pragma unroll
        for (int ai = 0; ai < 2; ++ai)
#pragma unroll
            for (int m = 0; m < 4; ++m) { const bf16_t* gp = P + (size_t)(row0 + ai * HALF + m * 16) * LDP + C_G + col0;
#pragma unroll
                for (int bj = 0; bj < 2; ++bj) { const u32x4 ga = *(const u32x4*)(gp + bj * HALF), gf = *(const u32x4*)(gp + 1024 + bj * HALF);
                    f32x4 r0, r1;
                    r0[0] = bflo(ga.x) * __builtin_amdgcn_rcpf(fmaxf(bflo(gf.x), 1e-30f)); r0[1] = bfhi(ga.x) * __builtin_amdgcn_rcpf(fmaxf(bfhi(gf.x), 1e-30f));
                    r0[2] = bflo(ga.y) * __builtin_amdgcn_rcpf(fmaxf(bflo(gf.y), 1e-30f)); r0[3] = bfhi(ga.y) * __builtin_amdgcn_rcpf(fmaxf(bfhi(gf.y), 1e-30f));
                    r1[0] = bflo(ga.z) * __builtin_amdgcn_rcpf(fmaxf(bflo(gf.z), 1e-30f)); r1[1] = bfhi(ga.z) * __builtin_amdgcn_rcpf(fmaxf(bfhi(gf.z), 1e-30f));
                    r1[2] = bflo(ga.w) * __builtin_amdgcn_rcpf(fmaxf(bflo(gf.w), 1e-30f)); r1[3] = bfhi(ga.w) * __builtin_amdgcn_rcpf(fmaxf(bfhi(gf.w), 1e-30f));
                    acc[ai][bj][m][0] *= r0; acc[ai][bj][m][1] *= r1; } }
    }
    __device__ __forceinline__ void operator()(const f32x4 (&acc)[2][2][4][2], const Unit& u, int wr, int wc, int fr, int fq) const {
        const int row0 = u.pm * BM + wr * 64 + fr, col0 = u.pn * BM + wc * 32 + 8 * fq;
#pragma unroll
        for (int ai = 0; ai < 2; ++ai)
#pragma unroll
            for (int m = 0; m < 4; ++m) { const size_t ro = (size_t)(row0 + ai * HALF + m * 16) * LDP + col0;
#pragma unroll
                for (int bj = 0; bj < 2; ++bj) { const u32x4 gf = *(const u32x4*)(P + ro + C_G + 1024 + bj * HALF);
                    const f32x4 v0 = acc[ai][bj][m][0], v1 = acc[ai][bj][m][1];
                    u32x4 w; w.x = cvt_pk_bf16(v0[0] * bflo(gf.x), v0[1] * bfhi(gf.x)); w.y = cvt_pk_bf16(v0[2] * bflo(gf.y), v0[3] * bfhi(gf.y));
                    w.z = cvt_pk_bf16(v1[0] * bflo(gf.z), v1[1] * bfhi(gf.z)); w.w = cvt_pk_bf16(v1[2] * bflo(gf.w), v1[3] * bfhi(gf.w));
                    *(u32x4*)(O + ro + bj * HALF) = w; } }
    }
};
struct EpiG4 {
    static constexpr bool PERM = true, AFTER_DRAIN = false, HAS_MID = false; static constexpr int MID_T = 0;
    const float* X; float* O;
    __device__ __forceinline__ void mid(f32x4 (&)[2][2][4][2], const Unit&, int, int, int, int) const {}
    __device__ __forceinline__ void operator()(const f32x4 (&acc)[2][2][4][2], const Unit& u, int wr, int wc, int fr, int fq) const {
        const int row0 = u.pm * BM + wr * 64 + fr, col0 = u.pn * BM + wc * 32 + 8 * fq;
#pragma unroll
        for (int ai = 0; ai < 2; ++ai)
#pragma unroll
            for (int m = 0; m < 4; ++m) { const size_t ro = (size_t)(row0 + ai * HALF + m * 16) * DM + col0;
#pragma unroll
                for (int bj = 0; bj < 2; ++bj) { const f32x4 x0 = *(const f32x4*)(X + ro + bj * HALF), x1 = *(const f32x4*)(X + ro + bj * HALF + 4);
                    *(f32x4*)(O + ro + bj * HALF) = x0 + acc[ai][bj][m][0]; *(f32x4*)(O + ro + bj * HALF + 4) = x1 + acc[ai][bj][m][1]; } }
    }
};
}

namespace att {
constexpr int D = 128, NW = 8, QBLK = 32, KVBLK = 64;
constexpr float SCALE = 0.088388347648318440f;
constexpr float THR = 8.f;
constexpr int LDQ = LDP, LDK = LDP;
constexpr size_t SHM_V = KVBLK * D * 2, SHM_K = KVBLK * D * 2, SHM_ATTN = 2 * SHM_V + 2 * SHM_K + NW * 64 * 4;
#define KSWZ(row, colB) ((row) * 256 + ((colB) ^ (((row) & 15) << 4)))
__device__ __forceinline__ int crow(int r, int hi) { return (r & 3) + 8 * (r >> 2) + 4 * hi; }
constexpr float THRL = THR * 1.4426950408889634f;
template <bool FIRST, bool DOEXP = true>
__device__ __forceinline__ void partialSM(f32x16& p0, f32x16& p1, float& m_reg, f32x16& negm, float& alpha, const bool track = true) {
  if (!FIRST && !track) { alpha = 1.f;
    if (DOEXP) {
#pragma unroll
      for (int r = 0; r < 16; ++r) p0[r] = __builtin_amdgcn_exp2f(p0[r]); }
    return; }
  float pmax = p0[0];
#pragma unroll
  for (int r = 1; r < 16; ++r) pmax = fmaxf(pmax, p0[r]);
#pragma unroll
  for (int r = 0; r < 16; ++r) pmax = fmaxf(pmax, p1[r]);
  { auto rr = __builtin_amdgcn_permlane32_swap(__float_as_uint(pmax), __float_as_uint(pmax), false, false);
    pmax = fmaxf(__uint_as_float(rr[0]), __uint_as_float(rr[1])); }
  if (!FIRST && __builtin_expect(__all(pmax <= THRL), 1)) { alpha = 1.f; }
  else { const float dl = FIRST ? pmax : fmaxf(pmax, 0.f); m_reg += dl; alpha = FIRST ? 1.f : __builtin_amdgcn_exp2f(-dl);
#pragma unroll
    for (int r = 0; r < 16; ++r) { p0[r] -= dl; p1[r] -= dl; }
#pragma unroll
    for (int r = 0; r < 16; ++r) negm[r] = -m_reg;
    asm volatile("" : "+v"(negm)); }
  if (DOEXP) {
#pragma unroll
    for (int r = 0; r < 16; ++r) p0[r] = __builtin_amdgcn_exp2f(p0[r]); }
}
__device__ __forceinline__ void finishSM(f32x16& p0, f32x16& p1, float alpha, float& l_reg, bf16x8& pa0, bf16x8& pa1, bf16x8& pa2, bf16x8& pa3) {
#pragma unroll
  for (int r = 0; r < 16; ++r) p1[r] = __builtin_amdgcn_exp2f(p1[r]);
  float ps = 0;
#pragma unroll
  for (int r = 0; r < 16; ++r) ps += p0[r];
#pragma unroll
  for (int r = 0; r < 16; ++r) ps += p1[r];
  asm volatile("" : "+v"(ps));
  l_reg = l_reg * alpha + ps;
#define PK4(P, BASE, OUT) do { u32x4 w = {cvtpk(P[BASE + 0], P[BASE + 1]), cvtpk(P[BASE + 2], P[BASE + 3]), cvtpk(P[BASE + 4], P[BASE + 5]), cvtpk(P[BASE + 6], P[BASE + 7])}; \
    OUT = *reinterpret_cast<bf16x8*>(&w); } while (0)
  PK4(p0, 0, pa0); PK4(p0, 8, pa1); PK4(p1, 0, pa2); PK4(p1, 8, pa3);
#undef PK4
}
__device__ __forceinline__ void qkt(f32x16& p0, f32x16& p1, const bf16_t* Ks, const bf16x8* qr, const f32x16& negm, int r32, int hi) {
#pragma unroll
  for (int d0 = 0; d0 < 8; ++d0) { int cb = (d0 * 16 + hi * 8) * 2;
    bf16x8 b0 = *reinterpret_cast<const bf16x8*>((const char*)Ks + KSWZ(r32, cb));
    bf16x8 b1 = *reinterpret_cast<const bf16x8*>((const char*)Ks + KSWZ(32 + r32, cb));
    if (d0 == 0) { p0 = __builtin_amdgcn_mfma_f32_32x32x16_bf16(b0, qr[0], negm, 0, 0, 0); p1 = __builtin_amdgcn_mfma_f32_32x32x16_bf16(b1, qr[0], negm, 0, 0, 0); }
    else { p0 = __builtin_amdgcn_mfma_f32_32x32x16_bf16(b0, qr[d0], p0, 0, 0, 0); p1 = __builtin_amdgcn_mfma_f32_32x32x16_bf16(b1, qr[d0], p1, 0, 0, 0); } }
}
__device__ __forceinline__ int v_st(int k, int c) { const int kk = (k & ~0xC) | ((k & 4) << 1) | ((k & 8) >> 1); return ((kk >> 3) * 4 + (c >> 5)) * 512 + ((kk & 7) * 32 + (c & 31)) * 2; }
__device__ __forceinline__ int v_st_nat(int k, int c) { return ((k >> 3) * 4 + (c >> 5)) * 512 + ((k & 7) * 32 + (c & 31)) * 2; }
__device__ __forceinline__ int v_rd_base(int lane) { return ((lane & 3) << 3) | (((lane >> 2) & 3) << 6) | (((lane >> 4) & 1) << 5) | (((lane >> 5) & 1) << 8); }
constexpr int v_rd_off(int d0, int ks, int half) { return d0 * 512 + ks * 4096 + half * 2048; }
template <int OFF> __device__ __forceinline__ s16x4 tr_read(int vb) {
  s16x4 r; asm volatile("ds_read_b64_tr_b16 %0, %1 offset:%2" : "=&v"(r) : "v"(vb), "i"(OFF) : "memory"); return r;
}
template <int D0> __device__ __forceinline__ void pv_one(f32x16& od, int vb, bf16x8 pa0, bf16x8 pa1, bf16x8 pa2, bf16x8 pa3) {
  const s16x4 l0 = tr_read<v_rd_off(D0, 0, 0)>(vb), h0 = tr_read<v_rd_off(D0, 0, 1)>(vb), l1 = tr_read<v_rd_off(D0, 1, 0)>(vb), h1 = tr_read<v_rd_off(D0, 1, 1)>(vb);
  const s16x4 l2 = tr_read<v_rd_off(D0, 2, 0)>(vb), h2 = tr_read<v_rd_off(D0, 2, 1)>(vb), l3 = tr_read<v_rd_off(D0, 3, 0)>(vb), h3 = tr_read<v_rd_off(D0, 3, 1)>(vb);
  asm volatile("s_waitcnt lgkmcnt(0)" ::: "memory"); SBAR();
#define PK(L, H) (bf16x8){L[0], L[1], L[2], L[3], H[0], H[1], H[2], H[3]}
  od = __builtin_amdgcn_mfma_f32_32x32x16_bf16(pa0, PK(l0, h0), od, 0, 0, 0);
  od = __builtin_amdgcn_mfma_f32_32x32x16_bf16(pa1, PK(l1, h1), od, 0, 0, 0);
  od = __builtin_amdgcn_mfma_f32_32x32x16_bf16(pa2, PK(l2, h2), od, 0, 0, 0);
  od = __builtin_amdgcn_mfma_f32_32x32x16_bf16(pa3, PK(l3, h3), od, 0, 0, 0);
#undef PK
}
__device__ __forceinline__ void pv_d0(f32x16* o, int vb, bf16x8 pa0, bf16x8 pa1, bf16x8 pa2, bf16x8 pa3) {
  pv_one<0>(o[0], vb, pa0, pa1, pa2, pa3); pv_one<1>(o[1], vb, pa0, pa1, pa2, pa3); pv_one<2>(o[2], vb, pa0, pa1, pa2, pa3); pv_one<3>(o[3], vb, pa0, pa1, pa2, pa3);
}

struct VF8 { s16x4 l0, h0, l1, h1, l2, h2, l3, h3; };
template <int D0> __device__ __forceinline__ void vf8_read(VF8& f, int vb) {
  f.l0 = tr_read<v_rd_off(D0, 0, 0)>(vb); f.h0 = tr_read<v_rd_off(D0, 0, 1)>(vb); f.l1 = tr_read<v_rd_off(D0, 1, 0)>(vb); f.h1 = tr_read<v_rd_off(D0, 1, 1)>(vb);
  f.l2 = tr_read<v_rd_off(D0, 2, 0)>(vb); f.h2 = tr_read<v_rd_off(D0, 2, 1)>(vb); f.l3 = tr_read<v_rd_off(D0, 3, 0)>(vb); f.h3 = tr_read<v_rd_off(D0, 3, 1)>(vb);
}
__device__ __forceinline__ void qkt_fin(f32x16& n0, f32x16& n1, const bf16_t* Ks, const bf16x8* qr, const f32x16& negm, int r32, int hi,
                                        f32x16& P0, f32x16& P1, float alpha, float& l_reg, bf16x8& pa0, bf16x8& pa1, bf16x8& pa2, bf16x8& pa3, VF8& vf0, const int vbv) {
  float psa = 0.f, psb = 0.f; u32x4 wa, wb, wc, wd;
#define QF_CHUNK(g) do { P1[g] = __builtin_amdgcn_exp2f(P1[g]); psa += P0[g]; if ((g) > 0) psb += P1[(g) > 0 ? (g) - 1 : 0];                                   \
    if ((g) & 1) { const unsigned w_ = cvtpk(P0[(g) - ((g) & 1)], P0[g]); if ((g) < 8) wa[((g) >> 1) & 3] = w_; else wb[((g) >> 1) & 3] = w_; }                    \
    if (((g) & 1) && (g) >= 3) { const unsigned w_ = cvtpk(P1[(g) >= 3 ? (g) - 3 : 0], P1[(g) >= 3 ? (g) - 2 : 0]); if ((g) < 11) wc[(((g) - 3) >> 1) & 3] = w_; else wd[(((g) - 3) >> 1) & 3] = w_; } \
    asm volatile("" : "+v"(P1), "+v"(psa), "+v"(psb)); } while (0)
#pragma unroll
  for (int d0 = 0; d0 < 8; ++d0) { int cb = (d0 * 16 + hi * 8) * 2;
    bf16x8 b0 = *reinterpret_cast<const bf16x8*>((const char*)Ks + KSWZ(r32, cb));
    bf16x8 b1 = *reinterpret_cast<const bf16x8*>((const char*)Ks + KSWZ(32 + r32, cb));
    SBAR(); if (d0 == 0) n0 = __builtin_amdgcn_mfma_f32_32x32x16_bf16(b0, qr[0], negm, 0, 0, 0); else n0 = __builtin_amdgcn_mfma_f32_32x32x16_bf16(b0, qr[d0], n0, 0, 0, 0);
    SBAR(); QF_CHUNK(2 * d0); SBAR();
    if (d0 == 0) n1 = __builtin_amdgcn_mfma_f32_32x32x16_bf16(b1, qr[0], negm, 0, 0, 0); else n1 = __builtin_amdgcn_mfma_f32_32x32x16_bf16(b1, qr[d0], n1, 0, 0, 0);
    SBAR(); QF_CHUNK(2 * d0 + 1); SBAR();
    if (d0 == 7) { vf8_read<0>(vf0, vbv); SBAR(); } }
#undef QF_CHUNK
  psb += P1[15]; wd[3] = cvtpk(P1[14], P1[15]);
  l_reg = l_reg * alpha + (psa + psb);
  pa0 = *reinterpret_cast<bf16x8*>(&wa); pa1 = *reinterpret_cast<bf16x8*>(&wb); pa2 = *reinterpret_cast<bf16x8*>(&wc); pa3 = *reinterpret_cast<bf16x8*>(&wd);
}

#define PKV(L, H) (bf16x8){L[0], L[1], L[2], L[3], H[0], H[1], H[2], H[3]}
#define PVE_M(OD, PA, L, H, IDX) do { OD = __builtin_amdgcn_mfma_f32_32x32x16_bf16(PA, PKV(L, H), OD, 0, 0, 0); SBAR(); p[IDX] = __builtin_amdgcn_exp2f(p[IDX]); asm volatile("" : "+v"(p)); SBAR(); } while (0)
__device__ __forceinline__ void pv_exp(f32x16* o, int vb, bf16x8 pa0, bf16x8 pa1, bf16x8 pa2, bf16x8 pa3, f32x16& p, VF8& fa) {
  VF8 fb;
  asm volatile("s_waitcnt lgkmcnt(0)" ::: "memory"); SBAR();
  PVE_M(o[0], pa0, fa.l0, fa.h0, 0); PVE_M(o[0], pa1, fa.l1, fa.h1, 1); vf8_read<1>(fb, vb); SBAR(); PVE_M(o[0], pa2, fa.l2, fa.h2, 2); PVE_M(o[0], pa3, fa.l3, fa.h3, 3);
  asm volatile("s_waitcnt lgkmcnt(0)" ::: "memory"); SBAR();
  PVE_M(o[1], pa0, fb.l0, fb.h0, 4); PVE_M(o[1], pa1, fb.l1, fb.h1, 5); vf8_read<2>(fa, vb); SBAR(); PVE_M(o[1], pa2, fb.l2, fb.h2, 6); PVE_M(o[1], pa3, fb.l3, fb.h3, 7);
  asm volatile("s_waitcnt lgkmcnt(0)" ::: "memory"); SBAR();
  PVE_M(o[2], pa0, fa.l0, fa.h0, 8); PVE_M(o[2], pa1, fa.l1, fa.h1, 9); vf8_read<3>(fb, vb); SBAR(); PVE_M(o[2], pa2, fa.l2, fa.h2, 10); PVE_M(o[2], pa3, fa.l3, fa.h3, 11);
  asm volatile("s_waitcnt lgkmcnt(0)" ::: "memory"); SBAR();
  PVE_M(o[3], pa0, fb.l0, fb.h0, 12); PVE_M(o[3], pa1, fb.l1, fb.h1, 13); PVE_M(o[3], pa2, fb.l2, fb.h2, 14); PVE_M(o[3], pa3, fb.l3, fb.h3, 15);
}
#undef PVE_M
#undef PKV

__device__ __forceinline__ void attn_item(const bf16_t* __restrict__ Qb, const bf16_t* __restrict__ Kh, const bf16_t* __restrict__ Vh, const bf16_t* __restrict__ Zb,
                                          bf16_t* __restrict__ Ob, int seq, char* lds, const int wid_s, const float* __restrict__ qg, const int qpos0, const float kmaxg) {
  int tid_ = MYTID(wid_s); asm volatile("" : "+v"(tid_)); const int tid = tid_, wid = tid >> 6, lane = tid & 63, r32 = lane & 31, hi = lane >> 5;
  constexpr int SLOT = 32768, KOFF = 16384, WSOFF = 3 * SLOT;
  float* ws = (float*)(lds + WSOFF) + wid * 64; float* al_l = ws + 32;
  float m_reg = 0.f, l_reg = 0; f32x16 o[4] = {}; bf16x8 qr[8]; f32x16 negm = f32x16{}; asm volatile("" : "+v"(negm));
  const bf16_t* Qw = Qb + (long)(wid * QBLK + r32) * LDQ + hi * 8;
  float qn2 = 0.f;
  {
    u32x4 qw[8];
#pragma unroll
    for (int d0 = 0; d0 < 8; ++d0) qw[d0] = *reinterpret_cast<const u32x4*>(Qw + d0 * 16);
    float ss = 0.f;
#pragma unroll
    for (int d0 = 0; d0 < 8; ++d0) { const float a0 = bflo(qw[d0].x), a1 = bfhi(qw[d0].x), a2 = bflo(qw[d0].y), a3 = bfhi(qw[d0].y), a4 = bflo(qw[d0].z), a5 = bfhi(qw[d0].z), a6 = bflo(qw[d0].w), a7 = bfhi(qw[d0].w);
      ss += (a0 * a0 + a1 * a1) + (a2 * a2 + a3 * a3) + (a4 * a4 + a5 * a5) + (a6 * a6 + a7 * a7); }
    { auto rr = __builtin_amdgcn_permlane32_swap(__float_as_uint(ss), __float_as_uint(ss), false, false); ss = __uint_as_float(rr[0]) + __uint_as_float(rr[1]); }
    const float rstd = __builtin_amdgcn_rsqf(ss * (1.0f / 128.0f) + NORM_EPS) * (SCALE * 1.4426950408889634f);
    const int hq = lane_id_asm() >> 5;
    const int spos = qpos0 + wid * QBLK + r32; const float prow = (float)(spos >> 6), pcol = (float)(spos & 63);
#pragma unroll
    for (int bb = 0; bb < 4; ++bb) { const int d1 = (bb & 1) + 4 * (bb >> 1), d2 = d1 + 2;
      const float pos = (bb < 2) ? prow : pcol; const float* g1p = qg + d1 * 16 + hq * 8; const float* g2p = qg + d2 * 16 + hq * 8;
      const f32x4 g1a = *(const f32x4*)g1p, g1b = *(const f32x4*)(g1p + 4), g2a = *(const f32x4*)g2p, g2b = *(const f32x4*)(g2p + 4);
      float o1[8], o2[8];
#pragma unroll
      for (int e = 0; e < 8; ++e) { const unsigned w1 = (e < 2) ? qw[d1].x : (e < 4) ? qw[d1].y : (e < 6) ? qw[d1].z : qw[d1].w, w2 = (e < 2) ? qw[d2].x : (e < 4) ? qw[d2].y : (e < 6) ? qw[d2].z : qw[d2].w;
        const float x1 = (e & 1) ? bfhi(w1) : bflo(w1), x2 = (e & 1) ? bfhi(w2) : bflo(w2); const float ga = (e < 4) ? g1a[e & 3] : g1b[e & 3], gb = (e < 4) ? g2a[e & 3] : g2b[e & 3];
        const int fi = (d1 & 1) * 16 + hq * 8 + e; float rev = pos * (__builtin_amdgcn_exp2f(-(float)fi * (13.287712379549449f / 32.0f)) * 0.15915494309189535f); rev -= floorf(rev);
        const float sn = sin_rev(rev), cs = cos_rev(rev), y1 = x1 * rstd * ga, y2 = x2 * rstd * gb; o1[e] = y1 * cs - y2 * sn; o2[e] = y2 * cs + y1 * sn; }
#pragma unroll
      for (int e = 0; e < 8; ++e) qn2 += o1[e] * o1[e] + o2[e] * o2[e];
      u32x4 p1 = {cvtpk(o1[0], o1[1]), cvtpk(o1[2], o1[3]), cvtpk(o1[4], o1[5]), cvtpk(o1[6], o1[7])}, p2 = {cvtpk(o2[0], o2[1]), cvtpk(o2[2], o2[3]), cvtpk(o2[4], o2[5]), cvtpk(o2[6], o2[7])};
      qr[d1] = *reinterpret_cast<bf16x8*>(&p1); qr[d2] = *reinterpret_cast<bf16x8*>(&p2); }
  }
  const int sr = tid >> 4, sc = (tid & 15) * 8, vst0 = v_st_nat(sr, sc), vst1 = v_st_nat(32 + sr, sc), kst0 = KOFF + KSWZ(sr, sc * 2), kst1 = KOFF + KSWZ(32 + sr, sc * 2);
  const int vb0 = (int)(uintptr_t)lds + v_rd_base(lane);
  struct { bf16x8 vs0, vs1, ks0, ks1; } sr_;
#define SLOAD(k0) do { sr_.vs0 = *(const bf16x8*)(&Vh[(long)((k0) + sr) * LDK + sc]); sr_.vs1 = *(const bf16x8*)(&Vh[(long)((k0) + 32 + sr) * LDK + sc]); \
    sr_.ks0 = *(const bf16x8*)(&Kh[(long)((k0) + sr) * LDK + sc]); sr_.ks1 = *(const bf16x8*)(&Kh[(long)((k0) + 32 + sr) * LDK + sc]); } while (0)
#define SWRITE(so) do { *(bf16x8*)(lds + (so) + vst0) = sr_.vs0; *(bf16x8*)(lds + (so) + vst1) = sr_.vs1;          \
    *(bf16x8*)(lds + (so) + kst0) = sr_.ks0; *(bf16x8*)(lds + (so) + kst1) = sr_.ks1; } while (0)
#define SWAIT() asm volatile("s_waitcnt vmcnt(0)" ::: "memory")
#define RESC(a) do { if (__any((a) < 1.f)) { if (hi == 0) al_l[r32] = (a); asm volatile("s_waitcnt lgkmcnt(0)" ::: "memory"); \
    _Pragma("unroll") for (int d = 0; d < 4; ++d) _Pragma("unroll") for (int r = 0; r < 16; ++r) o[d][r] *= al_l[crow(r, hi)]; } } while (0)
#define ROT() do { const int t_ = s_prev; s_prev = s_cur; s_cur = s_next; s_next = t_; } while (0)
  f32x16 pA0, pA1, pB0, pB1; float alA, alB; VF8 vfa; bf16x8 pa0, pa1, pa2, pa3; const int NT = seq / KVBLK;
  int s_prev = 0, s_cur = SLOT, s_next = 2 * SLOT;
  SLOAD(0); SWAIT(); SWRITE(0); __syncthreads();
  SLOAD(KVBLK);
  qkt(pA0, pA1, (const bf16_t*)(lds + KOFF), qr, negm, r32, hi); partialSM<true>(pA0, pA1, m_reg, negm, alA);
  { auto rr = __builtin_amdgcn_permlane32_swap(__float_as_uint(qn2), __float_as_uint(qn2), false, false); qn2 = __uint_as_float(rr[0]) + __uint_as_float(rr[1]); }
  const bool track = !__all(__builtin_sqrtf(qn2) * kmaxg - m_reg <= 90.f);
  SWAIT(); SWRITE(SLOT); __syncthreads();
  for (int j = 1; j + 1 < NT; j += 2) {
    SBAR(); SLOAD((j + 1) * KVBLK); SBAR();
    qkt_fin(pB0, pB1, (const bf16_t*)(lds + s_cur + KOFF), qr, negm, r32, hi, pA0, pA1, alA, l_reg, pa0, pa1, pa2, pa3, vfa, vb0 + s_prev); SBAR();
    partialSM<false, false>(pB0, pB1, m_reg, negm, alB, track); SBAR(); pv_exp(o, vb0 + s_prev, pa0, pa1, pa2, pa3, pB0, vfa);
    SWAIT(); SWRITE(s_next);
    RESC(alB); __syncthreads(); ROT();
    SBAR(); SLOAD((j + 2) * KVBLK); SBAR();
    qkt_fin(pA0, pA1, (const bf16_t*)(lds + s_cur + KOFF), qr, negm, r32, hi, pB0, pB1, alB, l_reg, pa0, pa1, pa2, pa3, vfa, vb0 + s_prev); SBAR();
    partialSM<false, false>(pA0, pA1, m_reg, negm, alA, track); SBAR(); pv_exp(o, vb0 + s_prev, pa0, pa1, pa2, pa3, pA0, vfa);
    SWAIT(); SWRITE(s_next);
    RESC(alA); __syncthreads(); ROT();
  }
  SBAR(); qkt_fin(pB0, pB1, (const bf16_t*)(lds + s_cur + KOFF), qr, negm, r32, hi, pA0, pA1, alA, l_reg, pa0, pa1, pa2, pa3, vfa, vb0 + s_prev); SBAR();
  partialSM<false, false>(pB0, pB1, m_reg, negm, alB, track); SBAR(); pv_exp(o, vb0 + s_prev, pa0, pa1, pa2, pa3, pB0, vfa);
  RESC(alB);
  finishSM(pB0, pB1, alB, l_reg, pa0, pa1, pa2, pa3); SBAR();
  pv_d0(o, vb0 + s_cur, pa0, pa1, pa2, pa3);
  __syncthreads();
  const int lane_e = lane_id_asm(), r32e = lane_e & 31, hie = lane_e >> 5;
  float* li_e = (float*)(lds + 3 * 32768) + wid_s * 64;
  { auto rr = __builtin_amdgcn_permlane32_swap(__float_as_uint(l_reg), __float_as_uint(l_reg), false, false); l_reg = __uint_as_float(rr[0]) + __uint_as_float(rr[1]); }
  if (hie == 0) li_e[r32e] = l_reg; asm volatile("s_waitcnt lgkmcnt(0)" ::: "memory");
  float rli[16];
#pragma unroll
  for (int r = 0; r < 16; ++r) rli[r] = __builtin_amdgcn_rcpf(li_e[crow(r, hie)]);
  bf16_t* Ow = Ob + (long)(wid_s * QBLK) * LDAF; const bf16_t* Zw = Zb + (long)(wid_s * QBLK) * LDP;
  bf16_t* stg = (bf16_t*)lds + wid_s * 4096;
#pragma unroll
  for (int r = 0; r < 16; ++r) { const int orow = crow(r, hie);
#pragma unroll
    for (int d0 = 0; d0 < 4; ++d0) stg[orow * 128 + d0 * 32 + r32e] = f2bf(o[d0][r] * rli[r]); }
  asm volatile("s_waitcnt lgkmcnt(0)" ::: "memory");
#pragma unroll
  for (int i = 0; i < 8; ++i) { const int row = i * 4 + (lane_e >> 4), ch = lane_e & 15;
    const u32x4 ov = *(const u32x4*)(stg + row * 128 + ch * 8); const u32x4 zv = *(const u32x4*)(Zw + (long)row * LDP + ch * 8);
    u32x4 w; w.x = cvtpk(bflo(ov.x) * bflo(zv.x), bfhi(ov.x) * bfhi(zv.x)); w.y = cvtpk(bflo(ov.y) * bflo(zv.y), bfhi(ov.y) * bfhi(zv.y));
    w.z = cvtpk(bflo(ov.z) * bflo(zv.z), bfhi(ov.z) * bfhi(zv.z)); w.w = cvtpk(bflo(ov.w) * bflo(zv.w), bfhi(ov.w) * bfhi(zv.w));
    *(u32x4*)(Ow + (long)row * LDAF + ch * 8) = w; }
  asm volatile("s_waitcnt lgkmcnt(0)" ::: "memory");
#undef ROT
#undef SLOAD
#undef SWRITE
#undef SWAIT
#undef RESC
}

template <int PASS>
__device__ __forceinline__ void fft_phase(unsigned char* wsb, char* lds, int G, int c, const int wid_s) {
  bf16_t* P1 = (bf16_t*)(wsb + WS_P1); bf16_t* AF = (bf16_t*)(wsb + WS_AF);
  const bf16_t* TAB = (const bf16_t*)(wsb + WS_TAB) + (PASS == 1 ? 0 : 256 * 256);
  int tid_ = MYTID(wid_s); asm volatile("" : "+v"(tid_)); const int tid = tid_, wid = tid >> 6, lane = tid & 63, r32 = lane & 31, hi = lane >> 5;
  const int wm = (PASS == 1) ? wid : (wid & 3), wn = (PASS == 1) ? 0 : (wid >> 2);
  bf16x8 pa[4][4];
#pragma unroll
  for (int kt = 0; kt < 4; ++kt)
#pragma unroll
    for (int ks = 0; ks < 4; ++ks) pa[kt][ks] = *(const bf16x8*)(TAB + (size_t)(32 * wm + r32) * 256 + 64 * kt + 16 * ks + 8 * hi);
  const int sr = tid >> 4, sc = (tid & 15) * 8, vst0 = v_st(sr, sc), vst1 = v_st(32 + sr, sc);
  const int vb0 = (int)(uintptr_t)lds + v_rd_base(lane) + wn * 1024;
  bf16x8 st[8];
#define FFT_LOAD(IT) do { const int g_ = (IT) & 3, idx_ = ((IT) >> 2) & 127, b_ = (IT) >> 9; const long rb_ = (long)b_ * SEQ + (PASS == 1 ? idx_ : idx_ * 128), rs_ = (PASS == 1) ? 128 : 1; \
    _Pragma("unroll") for (int kt = 0; kt < 4; ++kt) { const bf16_t* src = P1 + (kt < 2 ? C_ZR : C_ZI) + g_ * 128 + sc; const long row = rb_ + (long)(64 * (kt & 1) + sr) * rs_; \
      st[2 * kt] = *(const bf16x8*)(src + row * LDP); st[2 * kt + 1] = *(const bf16x8*)(src + (row + 32 * rs_) * LDP); } } while (0)
  if (c < 1024) FFT_LOAD(c);
  for (int it = c; it < 1024; it += G) {
    const int g = it & 3, idx = (it >> 2) & 127, b = it >> 9;
    __syncthreads();
#pragma unroll
    for (int kt = 0; kt < 4; ++kt) { *(bf16x8*)(lds + kt * 16384 + vst0) = st[2 * kt]; *(bf16x8*)(lds + kt * 16384 + vst1) = st[2 * kt + 1]; }
    __syncthreads();
    if (it + G < 1024) FFT_LOAD(it + G);
    if constexpr (PASS == 1) {
      f32x16 o[4] = {};
#pragma unroll
      for (int kt = 0; kt < 4; ++kt) pv_d0(o, vb0 + kt * 16384, pa[kt][0], pa[kt][1], pa[kt][2], pa[kt][3]);
      bf16_t* stg = (bf16_t*)(lds + 65536) + wid * 4096;
#pragma unroll
      for (int r = 0; r < 8; ++r) { const int k1l = crow(r, hi), k1 = 16 * wid + k1l; const float rev = (float)((k1 * idx) & 16383) * (1.0f / 16384.0f);
        const float sn = sin_rev(rev), cs = cos_rev(rev);
#pragma unroll
        for (int d0 = 0; d0 < 4; ++d0) { const float re = o[d0][r], im = o[d0][r + 8];
          stg[k1l * 128 + d0 * 32 + r32] = f2bf(re * cs + im * sn); stg[2048 + k1l * 128 + d0 * 32 + r32] = f2bf(im * cs - re * sn); } }
      asm volatile("s_waitcnt lgkmcnt(0)" ::: "memory");
#pragma unroll
      for (int i = 0; i < 8; ++i) { const int q = i * 64 + lane, part = q >> 8, k1l = (q >> 4) & 15, ch = q & 15;
        const u32x4 v = *(const u32x4*)(stg + part * 2048 + k1l * 128 + ch * 8);
        *(u32x4*)(P1 + ((long)b * SEQ + 128 * (16 * wid + k1l) + idx) * LDP + (part ? C_ZI : C_ZR) + g * 128 + ch * 8) = v; }
      asm volatile("s_waitcnt lgkmcnt(0)" ::: "memory");
    } else {
      f32x16 o[2] = {};
#pragma unroll
      for (int kt = 0; kt < 4; ++kt) { pv_one<0>(o[0], vb0 + kt * 16384, pa[kt][0], pa[kt][1], pa[kt][2], pa[kt][3]); pv_one<1>(o[1], vb0 + kt * 16384, pa[kt][0], pa[kt][1], pa[kt][2], pa[kt][3]); }
      constexpr float FS = 6.9053396600248786e-4f;
      float* stg = (float*)(lds + 65536) + wid * 2048;
#pragma unroll
      for (int r = 0; r < 16; ++r) { const int k2l = crow(r, hi);
#pragma unroll
        for (int d0 = 0; d0 < 2; ++d0) stg[k2l * 64 + d0 * 32 + r32] = o[d0][r] * FS; }
      asm volatile("s_waitcnt lgkmcnt(0)" ::: "memory");
#pragma unroll
      for (int i = 0; i < 4; ++i) { const int q = i * 64 + lane, k2l = q >> 3, ch = q & 7; const long row = (long)b * SEQ + idx + 128 * (32 * wm + k2l); const int col = g * 128 + wn * 64 + ch * 8;
        const f32x4 v0 = *(const f32x4*)(stg + k2l * 64 + ch * 8), v1 = *(const f32x4*)(stg + k2l * 64 + ch * 8 + 4); const u32x4 zv = *(const u32x4*)(P1 + row * LDP + C_ZF + col);
        u32x4 w; w.x = cvtpk(v0[0] * bflo(zv.x), v0[1] * bfhi(zv.x)); w.y = cvtpk(v0[2] * bflo(zv.y), v0[3] * bfhi(zv.y)); w.z = cvtpk(v1[0] * bflo(zv.z), v1[1] * bfhi(zv.z)); w.w = cvtpk(v1[2] * bflo(zv.w), v1[3] * bfhi(zv.w));
        *(u32x4*)(AF + row * LDAF + 1024 + col) = w; }
      asm volatile("s_waitcnt lgkmcnt(0)" ::: "memory");
    }
  }
#undef FFT_LOAD
  __syncthreads();
}
}

__device__ __forceinline__ void qk_fix(unsigned char* wsb, const float* qg, const float* kg, int G, int c, const int wid_s) {
  bf16_t* P1 = (bf16_t*)(wsb + WS_P1);
  int tid_ = MYTID(wid_s); asm volatile("" : "+v"(tid_)); const int tid = tid_, wid = tid >> 6, lane = tid & 63, sub = lane & 15, j = sub & 7, part = sub >> 3, grp = lane >> 4;
  const int e0 = part * 64 + 4 * j;
  const f32x4 gq1 = *(const f32x4*)(qg + e0), gq2 = *(const f32x4*)(qg + e0 + 32), gk1 = *(const f32x4*)(kg + e0), gk2 = *(const f32x4*)(kg + e0 + 32);
  float inv[4];
#pragma unroll
  for (int e = 0; e < 4; ++e) inv[e] = __builtin_amdgcn_exp2f(-(float)(4 * j + e) * (13.287712379549449f / 32.0f)) * 0.15915494309189535f;
  const long NT = (long)MROWS * 2, step = (long)G * 8 * 4;
  for (long t = ((long)wid * G + c) * 4 + grp; t < NT; t += step) {
    const int row = (int)(t >> 1), hh = 8 + (int)(t & 1);
    bf16_t* p = P1 + (long)row * LDP + hh * 128 + e0;
    const u32x2 a = *(const u32x2*)p, bq = *(const u32x2*)(p + 32);
    float x1[4] = {bflo(a.x), bfhi(a.x), bflo(a.y), bfhi(a.y)}, x2[4] = {bflo(bq.x), bfhi(bq.x), bflo(bq.y), bfhi(bq.y)};
    float ss = 0.f;
#pragma unroll
    for (int e = 0; e < 4; ++e) ss += x1[e] * x1[e] + x2[e] * x2[e];
    ss += __shfl_xor(ss, 1); ss += __shfl_xor(ss, 2); ss += __shfl_xor(ss, 4); ss += __shfl_xor(ss, 8);
    const float rstd = __builtin_amdgcn_rsqf(ss * (1.0f / 128.0f) + NORM_EPS);
    const f32x4 g1 = hh < 8 ? gq1 : gk1, g2 = hh < 8 ? gq2 : gk2;
    const int s = row & (SEQ - 1); const float pos = (float)(part == 0 ? (s >> 6) : (s & 63));
    float o1[4], o2[4];
#pragma unroll
    for (int e = 0; e < 4; ++e) { float rev = pos * inv[e]; rev -= floorf(rev); const float sn = sin_rev(rev), cs = cos_rev(rev);
      const float y1 = x1[e] * rstd * g1[e], y2 = x2[e] * rstd * g2[e]; o1[e] = y1 * cs - y2 * sn; o2[e] = y2 * cs + y1 * sn; }
    u32x2 w1, w2; w1.x = cvtpk(o1[0], o1[1]); w1.y = cvtpk(o1[2], o1[3]); w2.x = cvtpk(o2[0], o2[1]); w2.y = cvtpk(o2[2], o2[3]);
    *(u32x2*)p = w1; *(u32x2*)(p + 32) = w2;
  }
}

template <class F>
__device__ __forceinline__ void tr_item(F val, bf16_t* dst  , int ldt, LAS float* scr, int lane) {
#pragma unroll 4
  for (int i = 0; i < 32; ++i) { const int kk = 2 * i + (lane >> 5); scr[kk * 33 + (lane & 31)] = val(kk, lane & 31); }
  LDS_WAIT(); asm volatile("" ::: "memory");
  const int cc = lane & 7;
#pragma unroll
  for (int jj = 0; jj < 4; ++jj) { const int n = (lane >> 3) + 8 * jj; const LAS float* s = scr + (8 * cc) * 33 + n;
    u32x4 o; o.x = cvtpk(s[0 * 33], s[1 * 33]); o.y = cvtpk(s[2 * 33], s[3 * 33]); o.z = cvtpk(s[4 * 33], s[5 * 33]); o.w = cvtpk(s[6 * 33], s[7 * 33]);
    *(u32x4*)(dst + (size_t)n * ldt + 8 * cc) = o; }
  LDS_WAIT(); asm volatile("" ::: "memory");
}
template <class F>
__device__ __forceinline__ void tr_item16(F val, bf16_t* dst, int ldt, LAS float* scr, int lane) {
#pragma unroll
  for (int i = 0; i < 8; ++i) { const int kk = 2 * i + (lane >> 5); scr[kk * 33 + (lane & 31)] = val(kk, lane & 31); }
  LDS_WAIT(); asm volatile("" ::: "memory");
  { const int n = lane >> 1, cc = lane & 1; const LAS float* s = scr + (8 * cc) * 33 + n;
    u32x4 o; o.x = cvtpk(s[0 * 33], s[1 * 33]); o.y = cvtpk(s[2 * 33], s[3 * 33]); o.z = cvtpk(s[4 * 33], s[5 * 33]); o.w = cvtpk(s[6 * 33], s[7 * 33]);
    *(u32x4*)(dst + (size_t)n * ldt + 8 * cc) = o; }
  LDS_WAIT(); asm volatile("" ::: "memory");
}
struct Args { const float* in[10]; float* out; unsigned char* ws; };

__device__ __forceinline__ void p0_prologue(const Args& a, LAS unsigned char* ldsb, int G, int c, const int wid_s) {
  int tid_ = MYTID(wid_s); asm volatile("" : "+v"(tid_)); const int tid = tid_, wid = tid >> 6, lane = tid & 63;
  const float* x = a.in[0]; const float* norm_g = a.in[1]; const float* w_in = a.in[2]; const float* w_ap = a.in[5]; const float* w_fp = a.in[6]; const float* w_mg = a.in[7]; const float* w_out = a.in[9];
  bf16_t* W1T = (bf16_t*)(a.ws + WS_W1T); bf16_t* WCAT = (bf16_t*)(a.ws + WS_WCAT); bf16_t* WOUT = (bf16_t*)(a.ws + WS_WOUT); bf16_t* TAB = (bf16_t*)(a.ws + WS_TAB); bf16_t* H = (bf16_t*)(a.ws + WS_AF);
  LAS float* scr = (LAS float*)(ldsb + wid * 16384); LAS float* ct = scr + 2112; LAS float* st = ct + 128;
  ct[lane] = cos_rev((float)lane * (1.0f / 128.0f)); ct[lane + 64] = cos_rev((float)(lane + 64) * (1.0f / 128.0f));
  st[lane] = sin_rev((float)lane * (1.0f / 128.0f)); st[lane + 64] = sin_rev((float)(lane + 64) * (1.0f / 128.0f));
  LDS_WAIT(); asm volatile("" ::: "memory");
  const int gw = wid * G + c, NGW = 8 * G;
  constexpr int I0 = 2048, I1 = 1280, I2 = 256, I3 = 1024, I4 = 512, I5 = 256, I6 = 512, NITEMS = I0 + I1 + I2 + I3 + I4 + I5 + I6;
  for (int it = gw; it < NITEMS; it += NGW) {
    int r = it;
    if (r < I0) {
      const int kb = r >> 5, nb = r & 31, k0 = 16 * kb, n0 = 32 * nb, part = n0 >> 9, g = (n0 >> 7) & 3, cp0 = n0 & 127;
      const float* wrow = w_in + (size_t)k0 * 3584 + 2560 + g * 128; const LAS float* tb = part ? st : ct; const float sgn = part ? -1.f : 1.f;
      tr_item16([&](int kk, int nn) { const float* wr_ = wrow + (size_t)kk * 3584; const int cp = cp0 + nn; float s = 0.f;
#pragma unroll 8
          for (int cc = 0; cc < 128; ++cc) s += wr_[cc] * tb[(cc * cp) & 127];
          return s * sgn; }, W1T + (size_t)(C_ZR + n0) * 1024 + k0, 1024, scr, lane);
      continue; } r -= I0;
    if (r < I1) { const int kb = r / 80, nb = r % 80, k0 = 64 * kb, n0 = 32 * nb; const float* src = w_in + (size_t)k0 * 3584 + n0;
      tr_item([&](int kk, int nn) { return src[(size_t)kk * 3584 + nn]; }, W1T + (size_t)n0 * 1024 + k0, 1024, scr, lane); continue; } r -= I1;
    if (r < I2) { const int kb = r / 16, nb = r % 16, k0 = 64 * kb, n0 = 32 * nb; const float* src = w_in + (size_t)k0 * 3584 + 3072 + n0;
      tr_item([&](int kk, int nn) { return src[(size_t)kk * 3584 + nn]; }, W1T + (size_t)(C_ZF + n0) * 1024 + k0, 1024, scr, lane); continue; } r -= I2;
    if (r < I3) { const int kb = r / 64, nb = r % 64, k0 = 64 * kb, n0 = 32 * nb; const float* src = w_mg + (size_t)k0 * 2048 + n0;
      tr_item([&](int kk, int nn) { return src[(size_t)kk * 2048 + nn]; }, W1T + (size_t)(C_G + n0) * 1024 + k0, 1024, scr, lane); continue; } r -= I3;
    if (r < I4) { const int kb = r / 32, nb = r % 32, k0 = 64 * kb, n0 = 32 * nb; const float* src = w_ap + (size_t)k0 * 1024 + n0;
      tr_item([&](int kk, int nn) { return src[(size_t)kk * 1024 + nn]; }, WCAT + (size_t)n0 * 1536 + k0, 1536, scr, lane); continue; } r -= I4;
    if (r < I5) { const int kb = r / 32, nb = r % 32, k0 = 64 * kb, n0 = 32 * nb; const float* src = w_fp + (size_t)k0 * 1024 + n0;
      tr_item([&](int kk, int nn) { return src[(size_t)kk * 1024 + nn]; }, WCAT + (size_t)n0 * 1536 + 1024 + k0, 1536, scr, lane); continue; } r -= I5;
    { const int kb = r / 32, nb = r % 32, k0 = 64 * kb, n0 = 32 * nb; const float* src = w_out + (size_t)k0 * 1024 + n0;
      tr_item([&](int kk, int nn) { return src[(size_t)kk * 1024 + nn]; }, WOUT + (size_t)n0 * 1024 + k0, 1024, scr, lane); }
  }
  if (c == 0 && tid == 0) { const float* kg_ = a.in[4]; float gm = 0.f; for (int i = 0; i < 128; ++i) gm = fmaxf(gm, fabsf(kg_[i]));
    *(float*)(a.ws + WS_TAB + 262144) = gm * 11.313708499f * 1.02f; }
  for (int e = c * 512 + tid; e < 256 * 256 + 128 * 256; e += G * 512) {
    float v;
    if (e < 65536) { const int m = e >> 8, k = e & 255, w = m >> 5, i = m & 31, k1 = 16 * w + (i & 15), im = i >> 4, s1 = k & 127, pt = k >> 7;
      const float rev = (float)((k1 * s1) & 127) * (1.0f / 128.0f); const float cs = cos_rev(rev), sn = sin_rev(rev);
      v = (im == 0) ? (pt == 0 ? cs : sn) : (pt == 0 ? -sn : cs); }
    else { const int e2 = e - 65536, k2 = e2 >> 8, k = e2 & 255, s2 = k & 127, pt = k >> 7;
      const float rev = (float)((k2 * s2) & 127) * (1.0f / 128.0f); v = pt == 0 ? cos_rev(rev) : sin_rev(rev); }
    TAB[e] = f2bf(v);
  }
  f32x4 gn[4];
#pragma unroll
  for (int q = 0; q < 4; ++q) gn[q] = *(const f32x4*)(norm_g + 256 * q + 4 * lane);
  for (int m0 = gw * 4; m0 < MROWS; m0 += NGW * 4) {
    f32x4 v[4][4]; float ss[4];
#pragma unroll
    for (int rr = 0; rr < 4; ++rr) { const f32x4* xr = (const f32x4*)(x + (size_t)(m0 + rr) * DM) + lane;
#pragma unroll
      for (int q = 0; q < 4; ++q) v[rr][q] = xr[64 * q]; }
#pragma unroll
    for (int rr = 0; rr < 4; ++rr) { float s = 0.f;
#pragma unroll
      for (int q = 0; q < 4; ++q) s += (v[rr][q].x * v[rr][q].x + v[rr][q].y * v[rr][q].y) + (v[rr][q].z * v[rr][q].z + v[rr][q].w * v[rr][q].w);
      ss[rr] = s; }
#pragma unroll
    for (int o = 1; o < 64; o <<= 1) {
#pragma unroll
      for (int rr = 0; rr < 4; ++rr) ss[rr] += __shfl_xor(ss[rr], o); }
#pragma unroll
    for (int rr = 0; rr < 4; ++rr) { const float rstd = __builtin_amdgcn_rsqf(ss[rr] * (1.0f / DM) + NORM_EPS);
      u32x2* o8 = (u32x2*)(H + (size_t)(m0 + rr) * DM) + lane;
#pragma unroll
      for (int q = 0; q < 4; ++q) { u32x2 w; w.x = cvtpk(v[rr][q].x * rstd * gn[q].x, v[rr][q].y * rstd * gn[q].y); w.y = cvtpk(v[rr][q].z * rstd * gn[q].z, v[rr][q].w * rstd * gn[q].w); o8[64 * q] = w; } }
  }
}

#define XB_TMO      128
#define XB_XCNT(j)  (256  + 64 * (j))
#define XB_XSUB(j)  (1280 + 64 * (j))
#define XB_XGEN(j)  (2304 + 64 * (j))
#define XB_TOP      3328
#define XB_TOPGEN   3392
#define XCD_BAR_WORDS 3456
#define XB_SPIN_CAP (1u << 18)

__device__ __forceinline__ unsigned xb_ld(unsigned* p)              { return __hip_atomic_load(p, __ATOMIC_RELAXED, __HIP_MEMORY_SCOPE_AGENT); }
__device__ __forceinline__ unsigned xb_add(unsigned* p, unsigned v) { return __hip_atomic_fetch_add(p, v, __ATOMIC_RELAXED, __HIP_MEMORY_SCOPE_AGENT); }
__device__ __forceinline__ unsigned xb_xcc_id() { return (unsigned)__builtin_amdgcn_s_getreg((3 << 11) | 20) & 0xFu; }
#define XB_SPIN(cond, bar) do { unsigned _sp = 0; while (cond) { __builtin_amdgcn_s_sleep(1); \
    if ((++_sp & 255u) == 0u) { if (xb_ld(&(bar)[XB_TMO])) break; if (_sp > XB_SPIN_CAP) { atomicAdd(&(bar)[XB_TMO], 1u); break; } } } } while (0)

struct XcdBarrier {
    unsigned* bar; unsigned x;
    volatile LAS unsigned* st;
};

__device__ __forceinline__ XcdBarrier xcd_barrier_post(unsigned* bar, volatile LAS unsigned* st, const bool t0) {
    XcdBarrier b; b.bar = bar; b.x = xb_xcc_id(); b.st = st;
    if (t0) (void)xb_add(&bar[XB_XCNT(b.x)], 1u);
    return b;
}
__device__ __forceinline__ void xcd_barrier_complete(unsigned* bar, unsigned x, unsigned& nloc, unsigned& nx) {
    const unsigned G = gridDim.x * gridDim.y * gridDim.z;
    unsigned sum, cnt, mine, sp = 0u;
    for (;;) {
        sum = 0u; cnt = 0u; mine = 0u;
#pragma unroll
        for (unsigned j = 0; j < 16; ++j) { const unsigned c = xb_ld(&bar[XB_XCNT(j)]); sum += c; cnt += (c > 0u) ? 1u : 0u; mine = (j == x) ? c : mine; }
        if (sum == G) break;
        __builtin_amdgcn_s_sleep(1);
        if ((++sp & 255u) == 0u) { if (xb_ld(&bar[XB_TMO])) break; if (sp > XB_SPIN_CAP) { atomicAdd(&bar[XB_TMO], 1u); break; } }
    }
    nloc = mine > 0u ? mine : 1u; nx = cnt > 0u ? cnt : 1u;
}

__device__ __forceinline__ void xcd_barrier(const XcdBarrier& b, const bool t0) {
    asm volatile("s_waitcnt vmcnt(0)" ::: "memory");
    __syncthreads();
    if (t0) {
        unsigned* bar = b.bar;
        __builtin_amdgcn_s_waitcnt(0);
        unsigned nloc = b.st[0], nx = b.st[1];
        if (nloc == 0u) { xcd_barrier_complete(bar, b.x, nloc, nx); b.st[0] = nloc; b.st[1] = nx; }
        const unsigned old = xb_add(&bar[XB_XSUB(b.x)], 1u);
        const unsigned gen = old / nloc;
        if (old + 1u == (gen + 1u) * nloc) {
            __builtin_amdgcn_fence(__ATOMIC_RELEASE, "agent");
            asm volatile("s_waitcnt vmcnt(0)" ::: "memory");
            const unsigned og = xb_add(&bar[XB_TOP], 1u);
            const unsigned tg = og / nx;
            if (og + 1u == (tg + 1u) * nx) xb_add(&bar[XB_TOPGEN], 1u);
            else XB_SPIN(xb_ld(&bar[XB_TOPGEN]) == tg, bar);
            __builtin_amdgcn_fence(__ATOMIC_ACQUIRE, "agent");
            xb_add(&bar[XB_XGEN(b.x)], 1u);
            asm volatile("s_waitcnt vmcnt(0)" ::: "memory");
        } else {
            XB_SPIN(xb_ld(&bar[XB_XGEN(b.x)]) == gen, bar);
            __builtin_amdgcn_fence(__ATOMIC_ACQUIRE, "agent");
            asm volatile("s_waitcnt vmcnt(0)" ::: "memory");
        }
    }
    __syncthreads();
}

__global__ void __launch_bounds__(512, 2) fwd_megakernel(Args a) {
  extern __shared__ __attribute__((aligned(16))) unsigned char lds[];
  cg::grid_group grid = cg::this_grid();
  const int G = gridDim.x, c = blockIdx.x, wid_s = __builtin_amdgcn_readfirstlane((int)threadIdx.x >> 6);
  bf16_t* P1 = (bf16_t*)(a.ws + WS_P1); bf16_t* AF = (bf16_t*)(a.ws + WS_AF);
#ifndef PH
#define PH 255
#endif
  unsigned* BAR = (unsigned*)(a.ws + WS_CTL); volatile LAS unsigned* bst = (volatile LAS unsigned*)((LAS unsigned char*)lds + 147200);
  { const int l0 = lane_id_asm(); if (wid_s == 0 && l0 < 2) bst[l0] = 0u; }
  __syncthreads();
  const XcdBarrier xbar = xcd_barrier_post(BAR, bst, wid_s == 0 && lane_id_asm() == 0);
#define GRID_BAR() xcd_barrier(xbar, wid_s == 0 && lane_id_asm() == 0)
  if (a.out == nullptr) grid.sync();
  if (PH & 1) p0_prologue(a, (LAS unsigned char*)lds, G, c, wid_s);
  GRID_BAR();
  if (PH & 2) { pg8::Gemm g{(const bf16_t*)(a.ws + WS_AF), (const bf16_t*)(a.ws + WS_W1T), MROWS, LDP, DM, DM, DM}; pg8::StaticOrder S; S.init(MROWS, LDP, G, c);
    pg8::EpiG1 E{P1, a.in[8]};
    pg8::gemm_phase<pg8::EpiG1, pg8::StaticOrder, false, true>((LAS unsigned char*)lds, g, S, E, wid_s); }
  GRID_BAR();
  if (PH & 4) att::fft_phase<1>(a.ws, (char*)lds, G, c, wid_s);
  if (PH & 64) qk_fix(a.ws, a.in[3], a.in[4], G, c, wid_s);
  GRID_BAR();
  if (PH & 128) att::fft_phase<2>(a.ws, (char*)lds, G, c, wid_s);
  const float kmaxg = *(const float*)(a.ws + WS_TAB + 262144);
  if (PH & 8) for (int it = c; it < 1024; it += G) {
    const int xx = it & 7, rest = it >> 3, bk = xx >> 1, qb = (xx & 1) * 32 + (rest & 31), hq = rest >> 5, kvh = bk & 1, h = kvh * 4 + hq, b = bk >> 1;
    const long row0 = (long)b * SEQ + qb * 256;
    att::attn_item(P1 + row0 * LDP + C_Q + h * 128, P1 + (long)b * SEQ * LDP + C_K + kvh * 128, P1 + (long)b * SEQ * LDP + C_V + kvh * 128,
                   P1 + row0 * LDP + C_ZA + h * 128, AF + row0 * LDAF + h * 128, SEQ, (char*)lds, wid_s, a.in[3], qb * 256, kmaxg);
    __syncthreads();
  }
  GRID_BAR();
  if (PH & 16) { pg8::Gemm g{AF, (const bf16_t*)(a.ws + WS_WCAT), MROWS, DM, LDAF, LDAF, LDAF}; pg8::StaticOrder S; S.init(MROWS, DM, G, c);
    pg8::EpiG3 E{P1, P1 + C_MG};
    pg8::gemm_phase<pg8::EpiG3, pg8::StaticOrder, true, true>((LAS unsigned char*)lds, g, S, E, wid_s); }
  GRID_BAR();
  if (PH & 32) { pg8::Gemm g{P1 + C_MG, (const bf16_t*)(a.ws + WS_WOUT), MROWS, DM, DM, LDP, DM}; pg8::StaticOrder S; S.init(MROWS, DM, G, c);
    pg8::EpiG4 E{a.in[0], a.out};
    pg8::gemm_phase<pg8::EpiG4, pg8::StaticOrder, true, true>((LAS unsigned char*)lds, g, S, E, wid_s); }
}

extern "C" void kernel_launch(void* const* d_in, const int* in_sizes, int n_in, void* d_out, int out_size, void* d_ws, size_t ws_size, hipStream_t stream) {
  static int grid = 0;
  if (grid == 0) {
    if (n_in != 10 || in_sizes[0] != MROWS * DM || out_size != MROWS * DM || ws_size < WS_END) {
      fprintf(stderr, "kernel_launch: shape mismatch n_in %d in0 %d out %d ws %zu (need %zu)\n", n_in, n_in > 0 ? in_sizes[0] : -1, out_size, ws_size, (size_t)WS_END); grid = -1; return; }
    int dev = 0, cus = 0, per_cu = 0;
    hipGetDevice(&dev); hipDeviceGetAttribute(&cus, hipDeviceAttributeMultiprocessorCount, dev);
    if (hipFuncSetAttribute((const void*)fwd_megakernel, hipFuncAttributeMaxDynamicSharedMemorySize, LDS_BYTES) != hipSuccess) { fprintf(stderr, "kernel_launch: hipFuncSetAttribute failed\n"); grid = -1; return; }
    if (hipOccupancyMaxActiveBlocksPerMultiprocessor(&per_cu, (const void*)fwd_megakernel, 512, LDS_BYTES) != hipSuccess || per_cu < 1) { fprintf(stderr, "kernel_launch: occupancy query gave %d\n", per_cu); per_cu = 1; }
    (void)hipGetLastError();
    grid = cus * per_cu;
  }
  if (grid < 0) return;
  if (hipMemsetAsync((char*)d_ws + WS_CTL, 0, XCD_BAR_WORDS * 4, stream) != hipSuccess) { fprintf(stderr, "kernel_launch: hipMemsetAsync of the barrier words failed\n"); return; }
  Args a{};
  for (int i = 0; i < 10; ++i) a.in[i] = (const float*)d_in[i];
  a.out = (float*)d_out; a.ws = (unsigned char*)d_ws;
  void* args[] = {&a};
  hipError_t e = hipLaunchCooperativeKernel((const void*)fwd_megakernel, dim3(grid), dim3(512), args, LDS_BYTES, stream);
  if (e != hipSuccess) fprintf(stderr, "kernel_launch: cooperative launch failed: %s (grid %d)\n", hipGetErrorString(e), grid);
}
```

```cpp
#include <hip/hip_runtime.h>
#include <hip/hip_bf16.h>
#include <hip/hip_cooperative_groups.h>
#include <cstdio>
#include <cstdint>
#include <type_traits>
namespace cg = cooperative_groups;
namespace pg8 {
#define PG8_LAS __attribute__((address_space(3)))
typedef unsigned short bf16_t;
typedef short bf16x8 __attribute__((ext_vector_type(8)));
typedef float f32x4 __attribute__((ext_vector_type(4)));
typedef unsigned u32x4 __attribute__((ext_vector_type(4)));
constexpr int BM = 256, BK = 64, HALF = 128, HTB = HALF * BK * 2  , STAGE_BYTES = 8 * HTB, NXCD = 8, WGM = 8;

__host__ __device__ __forceinline__ int lds_byte(int r, int c) { const int st = (r >> 4) * 2 + (c >> 5), rr = r & 15, cc = c & 31, ob = rr * 64 + cc * 2; return st * 1024 + (ob ^ (((ob >> 9) & 1) << 5)); }
__host__ __device__ __forceinline__ void stage_rc(int b, int& R, int& C) { const int st = b / 1024, sb = b % 1024, swz = sb ^ (((sb >> 9) & 1) << 5); R = (st >> 1) * 16 + swz / 64; C = (st & 1) * 32 + (swz % 64) / 2; }
__host__ __device__ __forceinline__ int perm32(int rho) { const int n = rho >> 4, i = rho & 15; return 8 * (i >> 2) + 4 * n + (i & 3); }

struct Unit { int pm, pn; };
struct Gemm { const bf16_t* A; const bf16_t* Bt; int M, N, K, lda, ldb; };

struct StaticOrder {
    int nM, nN, nwg, G, c;
    __host__ __device__ void init(int M, int N, int G_, int c_) { nM = M / BM; nN = N / BM; nwg = nM * nN; G = G_; c = c_; }
    __host__ __device__ bool next(int i, Unit& u) const {
        const long L = (long)i * G + c; if (L >= nwg) return false;
        int wgid = (int)L; { const int q = nwg / NXCD, r = nwg % NXCD, xcd = wgid % NXCD, off = wgid / NXCD; wgid = (xcd < r ? xcd * (q + 1) : r * (q + 1) + (xcd - r) * q) + off; }
        const int nig = WGM * nN, gid = wgid / nig, fm = gid * WGM, gsz = (nM - fm) < WGM ? (nM - fm) : WGM;
        u.pm = fm + ((wgid % nig) % gsz); u.pn = (wgid % nig) / gsz; return true;
    }
    __device__ __forceinline__ void a_ready(const Unit&) const {}
    __device__ __forceinline__ void done(const Unit&) const {}
};

__device__ __forceinline__ unsigned cvt_pk_bf16(float lo, float hi) { unsigned r; asm volatile("v_cvt_pk_bf16_f32 %0, %1, %2" : "=v"(r) : "v"(lo), "v"(hi)); return r; }
template <class Epi, class Sched, bool ALIGN_EPI = false, bool SP2 = false>
__device__ __forceinline__ void gemm_phase(PG8_LAS unsigned char* lds, const Gemm g, const Sched& S, const Epi& E, const int wid_s) {
    int tid_; asm volatile("v_mbcnt_lo_u32_b32 %0, -1, 0\n\tv_mbcnt_hi_u32_b32 %0, -1, %0" : "=v"(tid_)); tid_ += wid_s * 64;
    const int tid = tid_, wid = __builtin_amdgcn_readfirstlane(tid >> 6), lane = tid & 63, wr = wid >> 2, wc = wid & 3, fr = lane & 15, fq = lane >> 4;
    const int K = g.K, nt = K / BK;
    unsigned voffA[2], voffB[2];
#pragma unroll
    for (int i = 0; i < 2; ++i) { int R, C; stage_rc(tid * 16 + i * 8192, R, C); const int Rb = Epi::PERM ? ((R & ~31) + perm32(R & 31)) : R;
        voffA[i] = (unsigned)(R * g.lda + C) * 2u; voffB[i] = (unsigned)(Rb * g.ldb + C) * 2u; }
    const size_t kstep = (size_t)(BK * 2);
    const size_t hstepA = (size_t)HALF * g.lda * 2, hstepB = (size_t)HALF * g.ldb * 2;
    const size_t tstepA = 2 * hstepA, tstepB = 2 * hstepB;
    const unsigned ldsw = (unsigned)wid * 1024u;
    const int aoff = lds_byte(wr * 64 + fr, fq * 8), boff = lds_byte(wc * 32 + fr, fq * 8);
#define PG8_SA(b, h) (((b) * 2 + (h)) * HTB)
#define PG8_SB(b, h) ((4 + (b) * 2 + (h)) * HTB)
#define PG8_STAGE(bufoff, gbase, voff) do { _Pragma("unroll") for (int _i = 0; _i < 2; ++_i) \
        __builtin_amdgcn_global_load_lds((const unsigned*)((const char*)(gbase) + (voff)[_i]), (PG8_LAS unsigned*)(lds + (bufoff) + ldsw + _i * 8192), 16, 0, 0); } while (0)
#define PG8_LDA(dst, b, h) do { _Pragma("unroll") for (int m = 0; m < 4; ++m) _Pragma("unroll") for (int k = 0; k < 2; ++k) dst[m][k] = *(const PG8_LAS bf16x8*)(lds + PG8_SA(b, h) + aoff + m * 2048 + k * 1024); } while (0)
#define PG8_LDB(dst, b, h) do { _Pragma("unroll") for (int n = 0; n < 2; ++n) _Pragma("unroll") for (int k = 0; k < 2; ++k) dst[n][k] = *(const PG8_LAS bf16x8*)(lds + PG8_SB(b, h) + boff + n * 2048 + k * 1024); } while (0)
#define PG8_MMA(ai, bj, At, Bt) do { __builtin_amdgcn_s_setprio(1); _Pragma("unroll") for (int m = 0; m < 4; ++m) _Pragma("unroll") for (int n = 0; n < 2; ++n) _Pragma("unroll") for (int k = 0; k < 2; ++k) \
        acc[ai][bj][m][n] = __builtin_amdgcn_mfma_f32_16x16x32_bf16(Bt[n][k], At[m][k], acc[ai][bj][m][n], 0, 0, 0); __builtin_amdgcn_s_setprio(0); } while (0)
#define PG8_WAIT_V(n) asm volatile("s_waitcnt vmcnt(" #n ")" ::: "memory")
#define PG8_WAIT_L(n) asm volatile("s_waitcnt lgkmcnt(" #n ")" ::: "memory")
#define PG8_BAR __builtin_amdgcn_s_barrier()
#define PG8_SCHED __builtin_amdgcn_sched_barrier(0)
    Unit cur, nxt; int ui = 0;
    if (!S.next(0, cur)) return;
    f32x4 acc[2][2][4][2];
#pragma unroll
    for (int a = 0; a < 2; ++a)
#pragma unroll
        for (int b = 0; b < 2; ++b)
#pragma unroll
            for (int m = 0; m < 4; ++m)
#pragma unroll
                for (int n = 0; n < 2; ++n) acc[a][b][m][n] = (f32x4){0.f, 0.f, 0.f, 0.f};
    bf16x8 At[4][2], B0[2][2], B1[2][2];
    const char* cA = (const char*)g.A + (size_t)cur.pm * tstepA; const char* cB = (const char*)g.Bt + (size_t)cur.pn * tstepB;
    S.a_ready(cur);
    if constexpr (SP2) {
        PG8_STAGE(PG8_SB(0, 0), cB, voffB); PG8_STAGE(PG8_SB(0, 1), cB + hstepB, voffB); PG8_STAGE(PG8_SA(0, 0), cA, voffA); PG8_STAGE(PG8_SA(0, 1), cA + hstepA, voffA);
        if (wr == 1) PG8_BAR;
        PG8_WAIT_V(2); PG8_BAR;
        PG8_STAGE(PG8_SB(1, 0), cB + kstep, voffB); PG8_STAGE(PG8_SA(1, 0), cA + kstep, voffA); PG8_STAGE(PG8_SB(1, 1), cB + hstepB + kstep, voffB);
        PG8_WAIT_V(6); PG8_BAR;
    } else {
        PG8_STAGE(PG8_SB(0, 0), cB, voffB); PG8_STAGE(PG8_SA(0, 0), cA, voffA); PG8_STAGE(PG8_SB(0, 1), cB + hstepB, voffB); PG8_STAGE(PG8_SA(0, 1), cA + hstepA, voffA);
        if (wr == 1) PG8_BAR;
        PG8_WAIT_V(4); PG8_BAR;
        PG8_STAGE(PG8_SB(1, 0), cB + kstep, voffB); PG8_STAGE(PG8_SA(1, 0), cA + kstep, voffA); PG8_STAGE(PG8_SB(1, 1), cB + hstepB + kstep, voffB);
        PG8_WAIT_V(6); PG8_BAR;
    }
    for (;;) {
        const bool has_next = S.next(ui + 1, nxt);
        const char* nA = has_next ? (const char*)g.A + (size_t)nxt.pm * tstepA : cA; const char* nB = has_next ? (const char*)g.Bt + (size_t)nxt.pn * tstepB : cB;
        for (int t = 0; t < nt; t += 2) {
            const bool last = (t == nt - 2);
            const char* a1 = cA + (size_t)(t + 1) * kstep;
            const char* a2 = last ? nA : cA + (size_t)(t + 2) * kstep; const char* b2 = last ? nB : cB + (size_t)(t + 2) * kstep;
            const char* a3 = a2 + kstep; const char* b3 = b2 + kstep;
            if (last && has_next) S.a_ready(nxt);
            if constexpr (Epi::HAS_MID) { if (t == Epi::MID_T) { asm volatile("" ::: "memory"); E.mid(acc, cur, wr, wc, fr, fq); asm volatile("" ::: "memory"); } }
            if constexpr (SP2) {
            PG8_LDB(B0, 0, 0); PG8_LDB(B1, 0, 1); PG8_SCHED; PG8_LDA(At, 0, 0); PG8_STAGE(PG8_SA(1, 1), a1 + hstepA, voffA);
            PG8_WAIT_V(8); PG8_WAIT_L(0); PG8_BAR; PG8_MMA(0, 0, At, B0); PG8_MMA(0, 1, At, B1); PG8_BAR; PG8_SCHED;
            PG8_LDA(At, 0, 1); PG8_STAGE(PG8_SB(0, 0), b2, voffB); PG8_STAGE(PG8_SB(0, 1), b2 + hstepB, voffB); PG8_STAGE(PG8_SA(0, 0), a2, voffA);
            PG8_WAIT_V(8); PG8_WAIT_L(0); PG8_BAR; PG8_MMA(1, 0, At, B0); PG8_MMA(1, 1, At, B1); PG8_BAR; PG8_SCHED;
            PG8_LDB(B0, 1, 0); PG8_LDB(B1, 1, 1); PG8_SCHED; PG8_LDA(At, 1, 0); PG8_STAGE(PG8_SA(0, 1), a2 + hstepA, voffA);
            PG8_WAIT_V(8); PG8_WAIT_L(0); PG8_BAR; PG8_MMA(0, 0, At, B0); PG8_MMA(0, 1, At, B1); PG8_BAR; PG8_SCHED;
            PG8_LDA(At, 1, 1); PG8_STAGE(PG8_SB(1, 0), b3, voffB); PG8_STAGE(PG8_SB(1, 1), b3 + hstepB, voffB); PG8_STAGE(PG8_SA(1, 0), a3, voffA);
            PG8_WAIT_V(8); PG8_WAIT_L(0); PG8_BAR; PG8_MMA(1, 0, At, B0); PG8_MMA(1, 1, At, B1); PG8_BAR; PG8_SCHED;
            } else {
            PG8_LDB(B0, 0, 0); PG8_SCHED; PG8_LDA(At, 0, 0); PG8_STAGE(PG8_SA(1, 1), a1 + hstepA, voffA);
            PG8_WAIT_L(8); PG8_BAR; PG8_WAIT_L(0); PG8_MMA(0, 0, At, B0); PG8_BAR; PG8_SCHED;
            PG8_LDB(B1, 0, 1); PG8_STAGE(PG8_SB(0, 0), b2, voffB);
            PG8_BAR; PG8_WAIT_L(0); PG8_MMA(0, 1, At, B1); PG8_BAR;
            PG8_LDA(At, 0, 1); PG8_STAGE(PG8_SA(0, 0), a2, voffA);
            PG8_BAR; PG8_WAIT_L(0); PG8_MMA(1, 0, At, B0); PG8_BAR; PG8_SCHED;
            PG8_STAGE(PG8_SB(0, 1), b2 + hstepB, voffB);
            PG8_WAIT_V(6); PG8_BAR; PG8_MMA(1, 1, At, B1); PG8_BAR;
            PG8_LDB(B0, 1, 0); PG8_SCHED; PG8_LDA(At, 1, 0); PG8_STAGE(PG8_SA(0, 1), a2 + hstepA, voffA);
            PG8_WAIT_L(8); PG8_BAR; PG8_WAIT_L(0); PG8_MMA(0, 0, At, B0); PG8_BAR; PG8_SCHED;
            PG8_LDB(B1, 1, 1); PG8_STAGE(PG8_SB(1, 0), b3, voffB);
            PG8_BAR; PG8_WAIT_L(0); PG8_MMA(0, 1, At, B1); PG8_BAR;
            PG8_LDA(At, 1, 1); PG8_STAGE(PG8_SA(1, 0), a3, voffA);
            PG8_BAR; PG8_WAIT_L(0); PG8_MMA(1, 0, At, B0); PG8_BAR; PG8_SCHED;
            PG8_STAGE(PG8_SB(1, 1), b3 + hstepB, voffB);
            PG8_WAIT_V(6); PG8_BAR; PG8_MMA(1, 1, At, B1); PG8_BAR;
            }
        }
        if constexpr (ALIGN_EPI) { if (wr == 0) PG8_BAR; }
        if constexpr (!Epi::AFTER_DRAIN) { E(acc, cur, wr, wc, fr, fq); S.done(cur); }
        if (!has_next) break;
#pragma unroll
        for (int a = 0; a < 2; ++a)
#pragma unroll
            for (int b = 0; b < 2; ++b)
#pragma unroll
                for (int m = 0; m < 4; ++m)
#pragma unroll
                    for (int n = 0; n < 2; ++n) acc[a][b][m][n] = (f32x4){0.f, 0.f, 0.f, 0.f};
        cur = nxt; cA = nA; cB = nB; ++ui;
        if constexpr (ALIGN_EPI) { if (wr == 1) PG8_BAR; }
    }
    PG8_WAIT_V(0);
    if constexpr (!ALIGN_EPI) { if (wr == 0) PG8_BAR; }
    PG8_BAR;
    if constexpr (Epi::AFTER_DRAIN) { E.fused(acc, cur, wr, wc, fr, fq, lds, wid, lane); S.done(cur); }
#undef PG8_SA
#undef PG8_SB
#undef PG8_STAGE
#undef PG8_LDA
#undef PG8_LDB
#undef PG8_MMA
#undef PG8_WAIT_V
#undef PG8_WAIT_L
#undef PG8_BAR
#undef PG8_SCHED
}
}

constexpr int BATCH = 2, SEQ = 16384, DM = 1024, MROWS = BATCH * SEQ;
constexpr int LDP = 4160;
constexpr int N1 = 6144;
constexpr int C_Q = 0, C_K = 1024, C_V = 1280, C_ZA = 1536, C_ZR = 2560, C_ZI = 3072, C_ZF = 3584, C_G = 4096;
constexpr int C_MG = 1536;
constexpr int LDAF = 1536;
constexpr size_t MiB = 1u << 20;
constexpr size_t WS_P1 = 0, WS_GT = 260 * MiB  , WS_AF = 388 * MiB, WS_W1T = 484 * MiB, WS_WCAT = 496 * MiB, WS_WOUT = 499 * MiB, WS_TAB = 501 * MiB, WS_CTL = WS_TAB + 262144 + 4096  , WS_END = 502 * MiB;
constexpr int LDS_BYTES = 147456;
constexpr float NORM_EPS = 1e-6f;

typedef unsigned short bf16_t;
typedef short bf16x8 __attribute__((ext_vector_type(8)));
typedef short s16x4 __attribute__((ext_vector_type(4)));
typedef float f32x4 __attribute__((ext_vector_type(4)));
typedef float f32x16 __attribute__((ext_vector_type(16)));
typedef unsigned u32x4 __attribute__((ext_vector_type(4)));
typedef unsigned u32x2 __attribute__((ext_vector_type(2)));
#define LAS __attribute__((address_space(3)))
#define LDS_WAIT() asm volatile("s_waitcnt lgkmcnt(0)" ::: "memory")
#define SBAR() __builtin_amdgcn_sched_barrier(0)
__device__ __forceinline__ int lane_id_asm() { int r; asm volatile("v_mbcnt_lo_u32_b32 %0, -1, 0\n\tv_mbcnt_hi_u32_b32 %0, -1, %0" : "=v"(r)); return r; }
#define MYTID(w) ((w) * 64 + lane_id_asm())

__device__ __forceinline__ unsigned cvtpk(float lo, float hi) { unsigned r; asm volatile("v_cvt_pk_bf16_f32 %0, %1, %2" : "=v"(r) : "v"(lo), "v"(hi)); return r; }
__device__ __forceinline__ bf16_t f2bf(float f) { return (bf16_t)(cvtpk(f, f) & 0xffffu); }
__device__ __forceinline__ float bf2f(bf16_t h) { return __uint_as_float((unsigned)h << 16); }
__device__ __forceinline__ float bflo(unsigned w) { return __uint_as_float(w << 16); }
__device__ __forceinline__ float bfhi(unsigned w) { return __uint_as_float(w & 0xffff0000u); }
__device__ __forceinline__ float sigm(float v) { return __builtin_amdgcn_rcpf(1.0f + __builtin_amdgcn_exp2f(-1.4426950408889634f * v)); }
__device__ __forceinline__ float sin_rev(float rev) { return __builtin_amdgcn_sinf(rev); }
__device__ __forceinline__ float cos_rev(float rev) { return __builtin_amdgcn_cosf(rev); }

__device__ __forceinline__ size_t gt_off(int pm, int pg, int wave, int ai, int m, int bj, int lane) { return (size_t)(pm * 8 + pg) * 65536 + (size_t)((((wave * 2 + ai) * 4 + m) * 2 + bj) * 512 + lane * 8); }
namespace pg8 {
struct EpiG1 {
    static constexpr bool PERM = true, AFTER_DRAIN = false, HAS_MID = false; static constexpr int MID_T = 0;
    bf16_t* O; bf16_t* GT; const float* bias;
    __device__ __forceinline__ void mid(f32x4 (&)[2][2][4][2], const Unit&, int, int, int, int) const {}
    __device__ __forceinline__ void operator()(const f32x4 (&acc)[2][2][4][2], const Unit& u, int wr, int wc, int fr, int fq) const {
        const int pn = u.pn;
        const int mode = (pn >= 16) ? 2 : (((pn >= 6 && pn < 10) || pn >= 14) ? 1 : 0);
        const int row0 = u.pm * BM + wr * 64 + fr, col0 = pn * BM + wc * 32 + 8 * fq;
        bf16_t* gt_b = GT + gt_off(u.pm, (pn - 16) & 7, wr * 4 + wc, 0, 0, 0, fq * 16 + fr);
        f32x4 bv[2][2];
#pragma unroll
        for (int bj = 0; bj < 2; ++bj)
#pragma unroll
            for (int n = 0; n < 2; ++n) bv[bj][n] = (mode == 2) ? *(const f32x4*)(bias + (col0 - C_G) + bj * HALF + 4 * n) : (f32x4){0.f, 0.f, 0.f, 0.f};
#pragma unroll
        for (int ai = 0; ai < 2; ++ai)
#pragma unroll
            for (int m = 0; m < 4; ++m) { bf16_t* rowp = O + (size_t)(row0 + ai * HALF + m * 16) * LDP + col0;
#pragma unroll
                for (int bj = 0; bj < 2; ++bj) { f32x4 v0 = acc[ai][bj][m][0] + bv[bj][0], v1 = acc[ai][bj][m][1] + bv[bj][1];
                    if (mode == 1) {
#pragma unroll
                        for (int e = 0; e < 4; ++e) { v0[e] = v0[e] * sigm(v0[e]); v1[e] = v1[e] * sigm(v1[e]); } }
                    else if (mode == 2) {
#pragma unroll
                        for (int e = 0; e < 4; ++e) { v0[e] = sigm(v0[e]); v1[e] = sigm(v1[e]); } }
                    u32x4 w; w.x = cvt_pk_bf16(v0[0], v0[1]); w.y = cvt_pk_bf16(v0[2], v0[3]); w.z = cvt_pk_bf16(v1[0], v1[1]); w.w = cvt_pk_bf16(v1[2], v1[3]);
                    if (mode == 2) *(u32x4*)(gt_b + ((ai * 4 + m) * 2 + bj) * 512) = w; else *(u32x4*)(rowp + bj * HALF) = w; } }
    }
};
struct EpiG3 {
    static constexpr bool PERM = true, AFTER_DRAIN = false, HAS_MID = true; static constexpr int MID_T = 16;
    const bf16_t* GT; bf16_t* O;
    __device__ __forceinline__ void mid(f32x4 (&acc)[2][2][4][2], const Unit& u, int wr, int wc, int fr, int fq) const {
        int l_ = fq * 16 + fr; asm volatile("" : "+v"(l_));
        const bf16_t* ga_b = GT + gt_off(u.pm, u.pn, wr * 4 + wc, 0, 0, 0, l_); const bf16_t* gf_b = GT + gt_off(u.pm, 4 + u.pn, wr * 4 + wc, 0, 0, 0, l_);
#pragma unroll
        for (int ai = 0; ai < 2; ++ai)
#pragma unroll
            for (int m = 0; m < 4; ++m) {
#pragma unroll
                for (int bj = 0; bj < 2; ++bj) { const u32x4 ga = *(const u32x4*)(ga_b + ((ai * 4 + m) * 2 + bj) * 512), gf = *(const u32x4*)(gf_b + ((ai * 4 + m) * 2 + bj) * 512);
                    f32x4 r0, r1;
                    r0[0] = bflo(ga.x) * __builtin_amdgcn_rcpf(fmaxf(bflo(gf.x), 1e-30f)); r0[1] = bfhi(ga.x) * __builtin_amdgcn_rcpf(fmaxf(bfhi(gf.x), 1e-30f));
                    r0[2] = bflo(ga.y) * __builtin_amdgcn_rcpf(fmaxf(bflo(gf.y), 1e-30f)); r0[3] = bfhi(ga.y) * __builtin_amdgcn_rcpf(fmaxf(bfhi(gf.y), 1e-30f));
                    r1[0] = bflo(ga.z) * __builtin_amdgcn_rcpf(fmaxf(bflo(gf.z), 1e-30f)); r1[1] = bfhi(ga.z) * __builtin_amdgcn_rcpf(fmaxf(bfhi(gf.z), 1e-30f));
                    r1[2] = bflo(ga.w) * __builtin_amdgcn_rcpf(fmaxf(bflo(gf.w), 1e-30f)); r1[3] = bfhi(ga.w) * __builtin_amdgcn_rcpf(fmaxf(bfhi(gf.w), 1e-30f));
                    acc[ai][bj][m][0] *= r0; acc[ai][bj][m][1] *= r1; }
                if (m & 1) asm volatile("" ::: "memory"); }
    }
    __device__ __forceinline__ void operator()(const f32x4 (&acc)[2][2][4][2], const Unit& u, int wr, int wc, int fr, int fq) const {
        const int row0 = u.pm * BM + wr * 64 + fr, col0 = u.pn * BM + wc * 32 + 8 * fq;
        int l_ = fq * 16 + fr; asm volatile("" : "+v"(l_));
        const bf16_t* gf_b = GT + gt_off(u.pm, 4 + u.pn, wr * 4 + wc, 0, 0, 0, l_);
#pragma unroll
        for (int ai = 0; ai < 2; ++ai)
#pragma unroll
            for (int m = 0; m < 4; ++m) { const size_t ro = (size_t)(row0 + ai * HALF + m * 16) * LDP + col0;
#pragma unroll
                for (int bj = 0; bj < 2; ++bj) { const u32x4 gf = *(const u32x4*)(gf_b + ((ai * 4 + m) * 2 + bj) * 512);
                    const f32x4 v0 = acc[ai][bj][m][0], v1 = acc[ai][bj][m][1];
                    u32x4 w; w.x = cvt_pk_bf16(v0[0] * bflo(gf.x), v0[1] * bfhi(gf.x)); w.y = cvt_pk_bf16(v0[2] * bflo(gf.y), v0[3] * bfhi(gf.y));
                    w.z = cvt_pk_bf16(v1[0] * bflo(gf.z), v1[1] * bfhi(gf.z)); w.w = cvt_pk_bf16(v1[2] * bflo(gf.w), v1[3] * bfhi(gf.w));
                    *(u32x4*)(O + ro + bj * HALF) = w; }
                asm volatile("" ::: "memory"); }
    }
};
struct EpiG4 {
    static constexpr bool PERM = true, AFTER_DRAIN = false, HAS_MID = false; static constexpr int MID_T = 0;
    const float* X; float* O;
    __device__ __forceinline__ void mid(f32x4 (&)[2][2][4][2], const Unit&, int, int, int, int) const {}
    __device__ __forceinline__ void operator()(const f32x4 (&acc)[2][2][4][2], const Unit& u, int wr, int wc, int fr, int fq) const {
        const int row0 = u.pm * BM + wr * 64 + fr, col0 = u.pn * BM + wc * 32 + 8 * fq;
#pragma unroll
        for (int ai = 0; ai < 2; ++ai)
#pragma unroll
            for (int m = 0; m < 4; ++m) { const size_t ro = (size_t)(row0 + ai * HALF + m * 16) * DM + col0;
#pragma unroll
                for (int bj = 0; bj < 2; ++bj) { const f32x4 x0 = *(const f32x4*)(X + ro + bj * HALF), x1 = *(const f32x4*)(X + ro + bj * HALF + 4);
                    *(f32x4*)(O + ro + bj * HALF) = x0 + acc[ai][bj][m][0]; *(f32x4*)(O + ro + bj * HALF + 4) = x1 + acc[ai][bj][m][1]; } }
    }
};
}

namespace att {
constexpr int D = 128, NW = 8, QBLK = 32, KVBLK = 64;
constexpr float SCALE = 0.088388347648318440f;
constexpr float THR = 8.f;
constexpr int LDQ = LDP, LDK = LDP;
constexpr size_t SHM_V = KVBLK * D * 2, SHM_K = KVBLK * D * 2, SHM_ATTN = 2 * SHM_V + 2 * SHM_K + NW * 64 * 4;
#define KSWZ(row, colB) ((row) * 256 + ((colB) ^ (((row) & 15) << 4)))
__device__ __forceinline__ int crow(int r, int hi) { return (r & 3) + 8 * (r >> 2) + 4 * hi; }
constexpr float THRL = THR * 1.4426950408889634f;
template <bool FIRST, bool DOEXP = true>
__device__ __forceinline__ void partialSM(f32x16& p0, f32x16& p1, float& m_reg, f32x16& negm, float& alpha, const bool track = true) {
  if (!FIRST && !track) { alpha = 1.f;
    if (DOEXP) {
#pragma unroll
      for (int r = 0; r < 16; ++r) p0[r] = __builtin_amdgcn_exp2f(p0[r]); }
    return; }
  float pmax = p0[0];
#pragma unroll
  for (int r = 1; r < 16; ++r) pmax = fmaxf(pmax, p0[r]);
#pragma unroll
  for (int r = 0; r < 16; ++r) pmax = fmaxf(pmax, p1[r]);
  { auto rr = __builtin_amdgcn_permlane32_swap(__float_as_uint(pmax), __float_as_uint(pmax), false, false);
    pmax = fmaxf(__uint_as_float(rr[0]), __uint_as_float(rr[1])); }
  if (!FIRST && __builtin_expect(__all(pmax <= THRL), 1)) { alpha = 1.f; }
  else { const float dl = FIRST ? pmax : fmaxf(pmax, 0.f); m_reg += dl; alpha = FIRST ? 1.f : __builtin_amdgcn_exp2f(-dl);
#pragma unroll
    for (int r = 0; r < 16; ++r) { p0[r] -= dl; p1[r] -= dl; }
#pragma unroll
    for (int r = 0; r < 16; ++r) negm[r] = -m_reg;
    asm volatile("" : "+v"(negm)); }
  if (DOEXP) {
#pragma unroll
    for (int r = 0; r < 16; ++r) p0[r] = __builtin_amdgcn_exp2f(p0[r]); }
}
__device__ __forceinline__ void finishSM(f32x16& p0, f32x16& p1, float alpha, float& l_reg, bf16x8& pa0, bf16x8& pa1, bf16x8& pa2, bf16x8& pa3) {
#pragma unroll
  for (int r = 0; r < 16; ++r) p1[r] = __builtin_amdgcn_exp2f(p1[r]);
  float ps = 0;
#pragma unroll
  for (int r = 0; r < 16; ++r) ps += p0[r];
#pragma unroll
  for (int r = 0; r < 16; ++r) ps += p1[r];
  asm volatile("" : "+v"(ps));
  l_reg = l_reg * alpha + ps;
#define PK4(P, BASE, OUT) do { u32x4 w = {cvtpk(P[BASE + 0], P[BASE + 1]), cvtpk(P[BASE + 2], P[BASE + 3]), cvtpk(P[BASE + 4], P[BASE + 5]), cvtpk(P[BASE + 6], P[BASE + 7])}; \
    OUT = *reinterpret_cast<bf16x8*>(&w); } while (0)
  PK4(p0, 0, pa0); PK4(p0, 8, pa1); PK4(p1, 0, pa2); PK4(p1, 8, pa3);
#undef PK4
}
__device__ __forceinline__ void qkt(f32x16& p0, f32x16& p1, const bf16_t* Ks, const bf16x8* qr, const f32x16& negm, int r32, int hi) {
#pragma unroll
  for (int d0 = 0; d0 < 8; ++d0) { int cb = (d0 * 16 + hi * 8) * 2;
    bf16x8 b0 = *reinterpret_cast<const bf16x8*>((const char*)Ks + KSWZ(r32, cb));
    bf16x8 b1 = *reinterpret_cast<const bf16x8*>((const char*)Ks + KSWZ(32 + r32, cb));
    if (d0 == 0) { p0 = __builtin_amdgcn_mfma_f32_32x32x16_bf16(b0, qr[0], negm, 0, 0, 0); p1 = __builtin_amdgcn_mfma_f32_32x32x16_bf16(b1, qr[0], negm, 0, 0, 0); }
    else { p0 = __builtin_amdgcn_mfma_f32_32x32x16_bf16(b0, qr[d0], p0, 0, 0, 0); p1 = __builtin_amdgcn_mfma_f32_32x32x16_bf16(b1, qr[d0], p1, 0, 0, 0); } }
}
__device__ __forceinline__ int v_st(int k, int c) { const int kk = (k & ~0xC) | ((k & 4) << 1) | ((k & 8) >> 1); return ((kk >> 3) * 4 + (c >> 5)) * 512 + ((kk & 7) * 32 + (c & 31)) * 2; }
__device__ __forceinline__ int v_st_nat(int k, int c) { return ((k >> 3) * 4 + (c >> 5)) * 512 + ((k & 7) * 32 + (c & 31)) * 2; }
__device__ __forceinline__ int v_rd_base(int lane) { return ((lane & 3) << 3) | (((lane >> 2) & 3) << 6) | (((lane >> 4) & 1) << 5) | (((lane >> 5) & 1) << 8); }
constexpr int v_rd_off(int d0, int ks, int half) { return d0 * 512 + ks * 4096 + half * 2048; }
template <int OFF> __device__ __forceinline__ s16x4 tr_read(int vb) {
  s16x4 r; asm volatile("ds_read_b64_tr_b16 %0, %1 offset:%2" : "=&v"(r) : "v"(vb), "i"(OFF) : "memory"); return r;
}
template <int D0> __device__ __forceinline__ void pv_one(f32x16& od, int vb, bf16x8 pa0, bf16x8 pa1, bf16x8 pa2, bf16x8 pa3) {
  const s16x4 l0 = tr_read<v_rd_off(D0, 0, 0)>(vb), h0 = tr_read<v_rd_off(D0, 0, 1)>(vb), l1 = tr_read<v_rd_off(D0, 1, 0)>(vb), h1 = tr_read<v_rd_off(D0, 1, 1)>(vb);
  const s16x4 l2 = tr_read<v_rd_off(D0, 2, 0)>(vb), h2 = tr_read<v_rd_off(D0, 2, 1)>(vb), l3 = tr_read<v_rd_off(D0, 3, 0)>(vb), h3 = tr_read<v_rd_off(D0, 3, 1)>(vb);
  asm volatile("s_waitcnt lgkmcnt(0)" ::: "memory"); SBAR();
#define PK(L, H) (bf16x8){L[0], L[1], L[2], L[3], H[0], H[1], H[2], H[3]}
  od = __builtin_amdgcn_mfma_f32_32x32x16_bf16(pa0, PK(l0, h0), od, 0, 0, 0);
  od = __builtin_amdgcn_mfma_f32_32x32x16_bf16(pa1, PK(l1, h1), od, 0, 0, 0);
  od = __builtin_amdgcn_mfma_f32_32x32x16_bf16(pa2, PK(l2, h2), od, 0, 0, 0);
  od = __builtin_amdgcn_mfma_f32_32x32x16_bf16(pa3, PK(l3, h3), od, 0, 0, 0);
#undef PK
}
__device__ __forceinline__ void pv_d0(f32x16* o, int vb, bf16x8 pa0, bf16x8 pa1, bf16x8 pa2, bf16x8 pa3) {
  pv_one<0>(o[0], vb, pa0, pa1, pa2, pa3); pv_one<1>(o[1], vb, pa0, pa1, pa2, pa3); pv_one<2>(o[2], vb, pa0, pa1, pa2, pa3); pv_one<3>(o[3], vb, pa0, pa1, pa2, pa3);
}

struct VF8 { s16x4 l0, h0, l1, h1, l2, h2, l3, h3; };
template <int D0> __device__ __forceinline__ void vf8_read(VF8& f, int vb) {
  f.l0 = tr_read<v_rd_off(D0, 0, 0)>(vb); f.h0 = tr_read<v_rd_off(D0, 0, 1)>(vb); f.l1 = tr_read<v_rd_off(D0, 1, 0)>(vb); f.h1 = tr_read<v_rd_off(D0, 1, 1)>(vb);
  f.l2 = tr_read<v_rd_off(D0, 2, 0)>(vb); f.h2 = tr_read<v_rd_off(D0, 2, 1)>(vb); f.l3 = tr_read<v_rd_off(D0, 3, 0)>(vb); f.h3 = tr_read<v_rd_off(D0, 3, 1)>(vb);
}
__device__ __forceinline__ void qkt_fin(f32x16& n0, f32x16& n1, const bf16_t* Ks, const bf16x8* qr, const f32x16& negm, int r32, int hi,
                                        f32x16& P0, f32x16& P1, float alpha, float& l_reg, bf16x8& pa0, bf16x8& pa1, bf16x8& pa2, bf16x8& pa3, VF8& vf0, const int vbv) {
  float psa = 0.f, psb = 0.f; u32x4 wa, wb, wc, wd;
#define QF_CHUNK(g) do { P1[g] = __builtin_amdgcn_exp2f(P1[g]); psa += P0[g]; if ((g) > 0) psb += P1[(g) > 0 ? (g) - 1 : 0];                                   \
    if ((g) & 1) { const unsigned w_ = cvtpk(P0[(g) - ((g) & 1)], P0[g]); if ((g) < 8) wa[((g) >> 1) & 3] = w_; else wb[((g) >> 1) & 3] = w_; }                    \
    if (((g) & 1) && (g) >= 3) { const unsigned w_ = cvtpk(P1[(g) >= 3 ? (g) - 3 : 0], P1[(g) >= 3 ? (g) - 2 : 0]); if ((g) < 11) wc[(((g) - 3) >> 1) & 3] = w_; else wd[(((g) - 3) >> 1) & 3] = w_; } \
    asm volatile("" : "+v"(P1), "+v"(psa), "+v"(psb)); } while (0)
#pragma unroll
  for (int d0 = 0; d0 < 8; ++d0) { int cb = (d0 * 16 + hi * 8) * 2;
    bf16x8 b0 = *reinterpret_cast<const bf16x8*>((const char*)Ks + KSWZ(r32, cb));
    bf16x8 b1 = *reinterpret_cast<const bf16x8*>((const char*)Ks + KSWZ(32 + r32, cb));
    SBAR(); if (d0 == 0) n0 = __builtin_amdgcn_mfma_f32_32x32x16_bf16(b0, qr[0], negm, 0, 0, 0); else n0 = __builtin_amdgcn_mfma_f32_32x32x16_bf16(b0, qr[d0], n0, 0, 0, 0);
    SBAR(); QF_CHUNK(2 * d0); SBAR();
    if (d0 == 0) n1 = __builtin_amdgcn_mfma_f32_32x32x16_bf16(b1, qr[0], negm, 0, 0, 0); else n1 = __builtin_amdgcn_mfma_f32_32x32x16_bf16(b1, qr[d0], n1, 0, 0, 0);
    SBAR(); QF_CHUNK(2 * d0 + 1); SBAR();
    if (d0 == 7) { vf8_read<0>(vf0, vbv); SBAR(); } }
#undef QF_CHUNK
  psb += P1[15]; wd[3] = cvtpk(P1[14], P1[15]);
  l_reg = l_reg * alpha + (psa + psb);
  pa0 = *reinterpret_cast<bf16x8*>(&wa); pa1 = *reinterpret_cast<bf16x8*>(&wb); pa2 = *reinterpret_cast<bf16x8*>(&wc); pa3 = *reinterpret_cast<bf16x8*>(&wd);
}

#define PKV(L, H) (bf16x8){L[0], L[1], L[2], L[3], H[0], H[1], H[2], H[3]}
#define PVE_M(OD, PA, L, H, IDX) do { OD = __builtin_amdgcn_mfma_f32_32x32x16_bf16(PA, PKV(L, H), OD, 0, 0, 0); SBAR(); p[IDX] = __builtin_amdgcn_exp2f(p[IDX]); asm volatile("" : "+v"(p)); SBAR(); } while (0)
__device__ __forceinline__ void pv_exp(f32x16* o, int vb, bf16x8 pa0, bf16x8 pa1, bf16x8 pa2, bf16x8 pa3, f32x16& p, VF8& fa) {
  VF8 fb;
  asm volatile("s_waitcnt lgkmcnt(0)" ::: "memory"); SBAR();
  PVE_M(o[0], pa0, fa.l0, fa.h0, 0); PVE_M(o[0], pa1, fa.l1, fa.h1, 1); vf8_read<1>(fb, vb); SBAR(); PVE_M(o[0], pa2, fa.l2, fa.h2, 2); PVE_M(o[0], pa3, fa.l3, fa.h3, 3);
  asm volatile("s_waitcnt lgkmcnt(0)" ::: "memory"); SBAR();
  PVE_M(o[1], pa0, fb.l0, fb.h0, 4); PVE_M(o[1], pa1, fb.l1, fb.h1, 5); vf8_read<2>(fa, vb); SBAR(); PVE_M(o[1], pa2, fb.l2, fb.h2, 6); PVE_M(o[1], pa3, fb.l3, fb.h3, 7);
  asm volatile("s_waitcnt lgkmcnt(0)" ::: "memory"); SBAR();
  PVE_M(o[2], pa0, fa.l0, fa.h0, 8); PVE_M(o[2], pa1, fa.l1, fa.h1, 9); vf8_read<3>(fb, vb); SBAR(); PVE_M(o[2], pa2, fa.l2, fa.h2, 10); PVE_M(o[2], pa3, fa.l3, fa.h3, 11);
  asm volatile("s_waitcnt lgkmcnt(0)" ::: "memory"); SBAR();
  PVE_M(o[3], pa0, fb.l0, fb.h0, 12); PVE_M(o[3], pa1, fb.l1, fb.h1, 13); PVE_M(o[3], pa2, fb.l2, fb.h2, 14); PVE_M(o[3], pa3, fb.l3, fb.h3, 15);
}
#undef PVE_M
#undef PKV

__device__ __forceinline__ void attn_item(const bf16_t* __restrict__ Qb, const bf16_t* __restrict__ Kh, const bf16_t* __restrict__ Vh, const bf16_t* __restrict__ Zb,
                                          bf16_t* __restrict__ Ob, int seq, char* lds, const int wid_s, const float* __restrict__ qg, const int qpos0, const float kmaxg) {
  int tid_ = MYTID(wid_s); asm volatile("" : "+v"(tid_)); const int tid = tid_, wid = tid >> 6, lane = tid & 63, r32 = lane & 31, hi = lane >> 5;
  constexpr int SLOT = 32768, KOFF = 16384, WSOFF = 3 * SLOT;
  float* ws = (float*)(lds + WSOFF) + wid * 64; float* al_l = ws + 32;
  float m_reg = 0.f, l_reg = 0; f32x16 o[4] = {}; bf16x8 qr[8]; f32x16 negm = f32x16{}; asm volatile("" : "+v"(negm));
  const bf16_t* Qw = Qb + (long)(wid * QBLK + r32) * LDQ + hi * 8;
  float qn2 = 0.f;
  {
    u32x4 qw[8];
#pragma unroll
    for (int d0 = 0; d0 < 8; ++d0) qw[d0] = *reinterpret_cast<const u32x4*>(Qw + d0 * 16);
    float ss = 0.f;
#pragma unroll
    for (int d0 = 0; d0 < 8; ++d0) { const float a0 = bflo(qw[d0].x), a1 = bfhi(qw[d0].x), a2 = bflo(qw[d0].y), a3 = bfhi(qw[d0].y), a4 = bflo(qw[d0].z), a5 = bfhi(qw[d0].z), a6 = bflo(qw[d0].w), a7 = bfhi(qw[d0].w);
      ss += (a0 * a0 + a1 * a1) + (a2 * a2 + a3 * a3) + (a4 * a4 + a5 * a5) + (a6 * a6 + a7 * a7); }
    { auto rr = __builtin_amdgcn_permlane32_swap(__float_as_uint(ss), __float_as_uint(ss), false, false); ss = __uint_as_float(rr[0]) + __uint_as_float(rr[1]); }
    const float rstd = __builtin_amdgcn_rsqf(ss * (1.0f / 128.0f) + NORM_EPS) * (SCALE * 1.4426950408889634f);
    const int hq = lane_id_asm() >> 5;
    const int spos = qpos0 + wid * QBLK + r32; const float prow = (float)(spos >> 6), pcol = (float)(spos & 63);
#pragma unroll
    for (int bb = 0; bb < 4; ++bb) { const int d1 = (bb & 1) + 4 * (bb >> 1), d2 = d1 + 2;
      const float pos = (bb < 2) ? prow : pcol; const float* g1p = qg + d1 * 16 + hq * 8; const float* g2p = qg + d2 * 16 + hq * 8;
      const f32x4 g1a = *(const f32x4*)g1p, g1b = *(const f32x4*)(g1p + 4), g2a = *(const f32x4*)g2p, g2b = *(const f32x4*)(g2p + 4);
      float o1[8], o2[8];
#pragma unroll
      for (int e = 0; e < 8; ++e) { const unsigned w1 = (e < 2) ? qw[d1].x : (e < 4) ? qw[d1].y : (e < 6) ? qw[d1].z : qw[d1].w, w2 = (e < 2) ? qw[d2].x : (e < 4) ? qw[d2].y : (e < 6) ? qw[d2].z : qw[d2].w;
        const float x1 = (e & 1) ? bfhi(w1) : bflo(w1), x2 = (e & 1) ? bfhi(w2) : bflo(w2); const float ga = (e < 4) ? g1a[e & 3] : g1b[e & 3], gb = (e < 4) ? g2a[e & 3] : g2b[e & 3];
        const int fi = (d1 & 1) * 16 + hq * 8 + e; float rev = pos * (__builtin_amdgcn_exp2f(-(float)fi * (13.287712379549449f / 32.0f)) * 0.15915494309189535f); rev -= floorf(rev);
        const float sn = sin_rev(rev), cs = cos_rev(rev), y1 = x1 * rstd * ga, y2 = x2 * rstd * gb; o1[e] = y1 * cs - y2 * sn; o2[e] = y2 * cs + y1 * sn; }
#pragma unroll
      for (int e = 0; e < 8; ++e) qn2 += o1[e] * o1[e] + o2[e] * o2[e];
      u32x4 p1 = {cvtpk(o1[0], o1[1]), cvtpk(o1[2], o1[3]), cvtpk(o1[4], o1[5]), cvtpk(o1[6], o1[7])}, p2 = {cvtpk(o2[0], o2[1]), cvtpk(o2[2], o2[3]), cvtpk(o2[4], o2[5]), cvtpk(o2[6], o2[7])};
      qr[d1] = *reinterpret_cast<bf16x8*>(&p1); qr[d2] = *reinterpret_cast<bf16x8*>(&p2); }
  }
  const int sr = tid >> 4, sc = (tid & 15) * 8, vst0 = v_st_nat(sr, sc), vst1 = v_st_nat(32 + sr, sc), kst0 = KOFF + KSWZ(sr, sc * 2), kst1 = KOFF + KSWZ(32 + sr, sc * 2);
  const int vb0 = (int)(uintptr_t)lds + v_rd_base(lane);
  struct { bf16x8 vs0, vs1, ks0, ks1; } sr_;
#define SLOAD(k0) do { sr_.vs0 = *(const bf16x8*)(&Vh[(long)((k0) + sr) * LDK + sc]); sr_.vs1 = *(const bf16x8*)(&Vh[(long)((k0) + 32 + sr) * LDK + sc]); \
    sr_.ks0 = *(const bf16x8*)(&Kh[(long)((k0) + sr) * LDK + sc]); sr_.ks1 = *(const bf16x8*)(&Kh[(long)((k0) + 32 + sr) * LDK + sc]); } while (0)
#define SWRITE(so) do { *(bf16x8*)(lds + (so) + vst0) = sr_.vs0; *(bf16x8*)(lds + (so) + vst1) = sr_.vs1;          \
    *(bf16x8*)(lds + (so) + kst0) = sr_.ks0; *(bf16x8*)(lds + (so) + kst1) = sr_.ks1; } while (0)
#define SWAIT() asm volatile("s_waitcnt vmcnt(0)" ::: "memory")
#define RESC(a) do { if (__any((a) < 1.f)) { if (hi == 0) al_l[r32] = (a); asm volatile("s_waitcnt lgkmcnt(0)" ::: "memory"); \
    _Pragma("unroll") for (int d = 0; d < 4; ++d) _Pragma("unroll") for (int r = 0; r < 16; ++r) o[d][r] *= al_l[crow(r, hi)]; } } while (0)
#define ROT() do { const int t_ = s_prev; s_prev = s_cur; s_cur = s_next; s_next = t_; } while (0)
  f32x16 pA0, pA1, pB0, pB1; float alA, alB; VF8 vfa; bf16x8 pa0, pa1, pa2, pa3; const int NT = seq / KVBLK;
  int s_prev = 0, s_cur = SLOT, s_next = 2 * SLOT;
  SLOAD(0); SWAIT(); SWRITE(0); __syncthreads();
  SLOAD(KVBLK);
  qkt(pA0, pA1, (const bf16_t*)(lds + KOFF), qr, negm, r32, hi); partialSM<true>(pA0, pA1, m_reg, negm, alA);
  { auto rr = __builtin_amdgcn_permlane32_swap(__float_as_uint(qn2), __float_as_uint(qn2), false, false); qn2 = __uint_as_float(rr[0]) + __uint_as_float(rr[1]); }
  const bool track = !__all(__builtin_sqrtf(qn2) * kmaxg - m_reg <= 90.f);
  SWAIT(); SWRITE(SLOT); __syncthreads();
  for (int j = 1; j + 1 < NT; j += 2) {
    SBAR(); SLOAD((j + 1) * KVBLK); SBAR();
    qkt_fin(pB0, pB1, (const bf16_t*)(lds + s_cur + KOFF), qr, negm, r32, hi, pA0, pA1, alA, l_reg, pa0, pa1, pa2, pa3, vfa, vb0 + s_prev); SBAR();
    partialSM<false, false>(pB0, pB1, m_reg, negm, alB, track); SBAR(); pv_exp(o, vb0 + s_prev, pa0, pa1, pa2, pa3, pB0, vfa);
    SWAIT(); SWRITE(s_next);
    RESC(alB); __syncthreads(); ROT();
    SBAR(); SLOAD((j + 2) * KVBLK); SBAR();
    qkt_fin(pA0, pA1, (const bf16_t*)(lds + s_cur + KOFF), qr, negm, r32, hi, pB0, pB1, alB, l_reg, pa0, pa1, pa2, pa3, vfa, vb0 + s_prev); SBAR();
    partialSM<false, false>(pA0, pA1, m_reg, negm, alA, track); SBAR(); pv_exp(o, vb0 + s_prev, pa0, pa1, pa2, pa3, pA0, vfa);
    SWAIT(); SWRITE(s_next);
    RESC(alA); __syncthreads(); ROT();
  }
  SBAR(); qkt_fin(pB0, pB1, (const bf16_t*)(lds + s_cur + KOFF), qr, negm, r32, hi, pA0, pA1, alA, l_reg, pa0, pa1, pa2, pa3, vfa, vb0 + s_prev); SBAR();
  partialSM<false, false>(pB0, pB1, m_reg, negm, alB, track); SBAR(); pv_exp(o, vb0 + s_prev, pa0, pa1, pa2, pa3, pB0, vfa);
  RESC(alB);
  finishSM(pB0, pB1, alB, l_reg, pa0, pa1, pa2, pa3); SBAR();
  pv_d0(o, vb0 + s_cur, pa0, pa1, pa2, pa3);
  __syncthreads();
  const int lane_e = lane_id_asm(), r32e = lane_e & 31, hie = lane_e >> 5;
  float* li_e = (float*)(lds + 3 * 32768) + wid_s * 64;
  { auto rr = __builtin_amdgcn_permlane32_swap(__float_as_uint(l_reg), __float_as_uint(l_reg), false, false); l_reg = __uint_as_float(rr[0]) + __uint_as_float(rr[1]); }
  if (hie == 0) li_e[r32e] = l_reg; asm volatile("s_waitcnt lgkmcnt(0)" ::: "memory");
  float rli[16];
#pragma unroll
  for (int r = 0; r < 16; ++r) rli[r] = __builtin_amdgcn_rcpf(li_e[crow(r, hie)]);
  bf16_t* Ow = Ob + (long)(wid_s * QBLK) * LDAF; const bf16_t* Zw = Zb + (long)(wid_s * QBLK) * LDP;
  bf16_t* stg = (bf16_t*)lds + wid_s * 4096;
#pragma unroll
  for (int r = 0; r < 16; ++r) { const int orow = crow(r, hie);
#pragma unroll
    for (int d0 = 0; d0 < 4; ++d0) stg[orow * 128 + d0 * 32 + r32e] = f2bf(o[d0][r] * rli[r]); }
  asm volatile("s_waitcnt lgkmcnt(0)" ::: "memory");
#pragma unroll
  for (int i = 0; i < 8; ++i) { const int row = i * 4 + (lane_e >> 4), ch = lane_e & 15;
    const u32x4 ov = *(const u32x4*)(stg + row * 128 + ch * 8); const u32x4 zv = *(const u32x4*)(Zw + (long)row * LDP + ch * 8);
    u32x4 w; w.x = cvtpk(bflo(ov.x) * bflo(zv.x), bfhi(ov.x) * bfhi(zv.x)); w.y = cvtpk(bflo(ov.y) * bflo(zv.y), bfhi(ov.y) * bfhi(zv.y));
    w.z = cvtpk(bflo(ov.z) * bflo(zv.z), bfhi(ov.z) * bfhi(zv.z)); w.w = cvtpk(bflo(ov.w) * bflo(zv.w), bfhi(ov.w) * bfhi(zv.w));
    *(u32x4*)(Ow + (long)row * LDAF + ch * 8) = w; }
  asm volatile("s_waitcnt lgkmcnt(0)" ::: "memory");
#undef ROT
#undef SLOAD
#undef SWRITE
#undef SWAIT
#undef RESC
}

template <int PASS>
__device__ __forceinline__ void fft_phase(unsigned char* wsb, char* lds, int G, int c, const int wid_s) {
  bf16_t* P1 = (bf16_t*)(wsb + WS_P1); bf16_t* AF = (bf16_t*)(wsb + WS_AF);
  const bf16_t* TAB = (const bf16_t*)(wsb + WS_TAB) + (PASS == 1 ? 0 : 256 * 256);
  int tid_ = MYTID(wid_s); asm volatile("" : "+v"(tid_)); const int tid = tid_, wid = tid >> 6, lane = tid & 63, r32 = lane & 31, hi = lane >> 5;
  const int wm = (PASS == 1) ? wid : (wid & 3), wn = (PASS == 1) ? 0 : (wid >> 2);
  bf16x8 pa[4][4];
#pragma unroll
  for (int kt = 0; kt < 4; ++kt)
#pragma unroll
    for (int ks = 0; ks < 4; ++ks) pa[kt][ks] = *(const bf16x8*)(TAB + (size_t)(32 * wm + r32) * 256 + 64 * kt + 16 * ks + 8 * hi);
  const int sr = tid >> 4, sc = (tid & 15) * 8, vst0 = v_st(sr, sc), vst1 = v_st(32 + sr, sc);
  const int vb0 = (int)(uintptr_t)lds + v_rd_base(lane) + wn * 1024;
  bf16x8 st[8];
#define FFT_LOAD(IT) do { const int g_ = (IT) & 3, idx_ = ((IT) >> 2) & 127, b_ = (IT) >> 9; const long rb_ = (long)b_ * SEQ + (PASS == 1 ? idx_ : idx_ * 128), rs_ = (PASS == 1) ? 128 : 1; \
    _Pragma("unroll") for (int kt = 0; kt < 4; ++kt) { const bf16_t* src = P1 + (kt < 2 ? C_ZR : C_ZI) + g_ * 128 + sc; const long row = rb_ + (long)(64 * (kt & 1) + sr) * rs_; \
      st[2 * kt] = *(const bf16x8*)(src + row * LDP); st[2 * kt + 1] = *(const bf16x8*)(src + (row + 32 * rs_) * LDP); } } while (0)
  if (c < 1024) FFT_LOAD(c);
  for (int it = c; it < 1024; it += G) {
    const int g = it & 3, idx = (it >> 2) & 127, b = it >> 9;
    __syncthreads();
#pragma unroll
    for (int kt = 0; kt < 4; ++kt) { *(bf16x8*)(lds + kt * 16384 + vst0) = st[2 * kt]; *(bf16x8*)(lds + kt * 16384 + vst1) = st[2 * kt + 1]; }
    __syncthreads();
    if (it + G < 1024) FFT_LOAD(it + G);
    if constexpr (PASS == 1) {
      f32x16 o[4] = {};
#pragma unroll
      for (int kt = 0; kt < 4; ++kt) pv_d0(o, vb0 + kt * 16384, pa[kt][0], pa[kt][1], pa[kt][2], pa[kt][3]);
      bf16_t* stg = (bf16_t*)(lds + 65536) + wid * 4096;
#pragma unroll
      for (int r = 0; r < 8; ++r) { const int k1l = crow(r, hi), k1 = 16 * wid + k1l; const float rev = (float)((k1 * idx) & 16383) * (1.0f / 16384.0f);
        const float sn = sin_rev(rev), cs = cos_rev(rev);
#pragma unroll
        for (int d0 = 0; d0 < 4; ++d0) { const float re = o[d0][r], im = o[d0][r + 8];
          stg[k1l * 128 + d0 * 32 + r32] = f2bf(re * cs + im * sn); stg[2048 + k1l * 128 + d0 * 32 + r32] = f2bf(im * cs - re * sn); } }
      asm volatile("s_waitcnt lgkmcnt(0)" ::: "memory");
#pragma unroll
      for (int i = 0; i < 8; ++i) { const int q = i * 64 + lane, part = q >> 8, k1l = (q >> 4) & 15, ch = q & 15;
        const u32x4 v = *(const u32x4*)(stg + part * 2048 + k1l * 128 + ch * 8);
        *(u32x4*)(P1 + ((long)b * SEQ + 128 * (16 * wid + k1l) + idx) * LDP + (part ? C_ZI : C_ZR) + g * 128 + ch * 8) = v; }
      asm volatile("s_waitcnt lgkmcnt(0)" ::: "memory");
    } else {
      f32x16 o[2] = {};
#pragma unroll
      for (int kt = 0; kt < 4; ++kt) { pv_one<0>(o[0], vb0 + kt * 16384, pa[kt][0], pa[kt][1], pa[kt][2], pa[kt][3]); pv_one<1>(o[1], vb0 + kt * 16384, pa[kt][0], pa[kt][1], pa[kt][2], pa[kt][3]); }
      constexpr float FS = 6.9053396600248786e-4f;
      float* stg = (float*)(lds + 65536) + wid * 2048;
#pragma unroll
      for (int r = 0; r < 16; ++r) { const int k2l = crow(r, hi);
#pragma unroll
        for (int d0 = 0; d0 < 2; ++d0) stg[k2l * 64 + d0 * 32 + r32] = o[d0][r] * FS; }
      asm volatile("s_waitcnt lgkmcnt(0)" ::: "memory");
#pragma unroll
      for (int i = 0; i < 4; ++i) { const int q = i * 64 + lane, k2l = q >> 3, ch = q & 7; const long row = (long)b * SEQ + idx + 128 * (32 * wm + k2l); const int col = g * 128 + wn * 64 + ch * 8;
        const f32x4 v0 = *(const f32x4*)(stg + k2l * 64 + ch * 8), v1 = *(const f32x4*)(stg + k2l * 64 + ch * 8 + 4); const u32x4 zv = *(const u32x4*)(P1 + row * LDP + C_ZF + col);
        u32x4 w; w.x = cvtpk(v0[0] * bflo(zv.x), v0[1] * bfhi(zv.x)); w.y = cvtpk(v0[2] * bflo(zv.y), v0[3] * bfhi(zv.y)); w.z = cvtpk(v1[0] * bflo(zv.z), v1[1] * bfhi(zv.z)); w.w = cvtpk(v1[2] * bflo(zv.w), v1[3] * bfhi(zv.w));
        *(u32x4*)(AF + row * LDAF + 1024 + col) = w; }
      asm volatile("s_waitcnt lgkmcnt(0)" ::: "memory");
    }
  }
#undef FFT_LOAD
  __syncthreads();
}
}

__device__ __forceinline__ void qk_fix(unsigned char* wsb, const float* qg, const float* kg, int G, int c, const int wid_s) {
  bf16_t* P1 = (bf16_t*)(wsb + WS_P1);
  int tid_ = MYTID(wid_s); asm volatile("" : "+v"(tid_)); const int tid = tid_, wid = tid >> 6, lane = tid & 63, sub = lane & 15, j = sub & 7, part = sub >> 3, grp = lane >> 4;
  const int e0 = part * 64 + 4 * j;
  const f32x4 gq1 = *(const f32x4*)(qg + e0), gq2 = *(const f32x4*)(qg + e0 + 32), gk1 = *(const f32x4*)(kg + e0), gk2 = *(const f32x4*)(kg + e0 + 32);
  float inv[4];
#pragma unroll
  for (int e = 0; e < 4; ++e) inv[e] = __builtin_amdgcn_exp2f(-(float)(4 * j + e) * (13.287712379549449f / 32.0f)) * 0.15915494309189535f;
  const long NT = (long)MROWS * 2, step = (long)G * 8 * 4;
  for (long t = ((long)wid * G + c) * 4 + grp; t < NT; t += step) {
    const int row = (int)(t >> 1), hh = 8 + (int)(t & 1);
    bf16_t* p = P1 + (long)row * LDP + hh * 128 + e0;
    const u32x2 a = *(const u32x2*)p, bq = *(const u32x2*)(p + 32);
    float x1[4] = {bflo(a.x), bfhi(a.x), bflo(a.y), bfhi(a.y)}, x2[4] = {bflo(bq.x), bfhi(bq.x), bflo(bq.y), bfhi(bq.y)};
    float ss = 0.f;
#pragma unroll
    for (int e = 0; e < 4; ++e) ss += x1[e] * x1[e] + x2[e] * x2[e];
    ss += __shfl_xor(ss, 1); ss += __shfl_xor(ss, 2); ss += __shfl_xor(ss, 4); ss += __shfl_xor(ss, 8);
    const float rstd = __builtin_amdgcn_rsqf(ss * (1.0f / 128.0f) + NORM_EPS);
    const f32x4 g1 = hh < 8 ? gq1 : gk1, g2 = hh < 8 ? gq2 : gk2;
    const int s = row & (SEQ - 1); const float pos = (float)(part == 0 ? (s >> 6) : (s & 63));
    float o1[4], o2[4];
#pragma unroll
    for (int e = 0; e < 4; ++e) { float rev = pos * inv[e]; rev -= floorf(rev); const float sn = sin_rev(rev), cs = cos_rev(rev);
      const float y1 = x1[e] * rstd * g1[e], y2 = x2[e] * rstd * g2[e]; o1[e] = y1 * cs - y2 * sn; o2[e] = y2 * cs + y1 * sn; }
    u32x2 w1, w2; w1.x = cvtpk(o1[0], o1[1]); w1.y = cvtpk(o1[2], o1[3]); w2.x = cvtpk(o2[0], o2[1]); w2.y = cvtpk(o2[2], o2[3]);
    *(u32x2*)p = w1; *(u32x2*)(p + 32) = w2;
  }
}

template <class F>
__device__ __forceinline__ void tr_item(F val, bf16_t* dst  , int ldt, LAS float* scr, int lane) {
#pragma unroll 4
  for (int i = 0; i < 32; ++i) { const int kk = 2 * i + (lane >> 5); scr[kk * 33 + (lane & 31)] = val(kk, lane & 31); }
  LDS_WAIT(); asm volatile("" ::: "memory");
  const int cc = lane & 7;
#pragma unroll
  for (int jj = 0; jj < 4; ++jj) { const int n = (lane >> 3) + 8 * jj; const LAS float* s = scr + (8 * cc) * 33 + n;
    u32x4 o; o.x = cvtpk(s[0 * 33], s[1 * 33]); o.y = cvtpk(s[2 * 33], s[3 * 33]); o.z = cvtpk(s[4 * 33], s[5 * 33]); o.w = cvtpk(s[6 * 33], s[7 * 33]);
    *(u32x4*)(dst + (size_t)n * ldt + 8 * cc) = o; }
  LDS_WAIT(); asm volatile("" ::: "memory");
}
template <class F>
__device__ __forceinline__ void tr_item16(F val, bf16_t* dst, int ldt, LAS float* scr, int lane) {
#pragma unroll
  for (int i = 0; i < 8; ++i) { const int kk = 2 * i + (lane >> 5); scr[kk * 33 + (lane & 31)] = val(kk, lane & 31); }
  LDS_WAIT(); asm volatile("" ::: "memory");
  { const int n = lane >> 1, cc = lane & 1; const LAS float* s = scr + (8 * cc) * 33 + n;
    u32x4 o; o.x = cvtpk(s[0 * 33], s[1 * 33]); o.y = cvtpk(s[2 * 33], s[3 * 33]); o.z = cvtpk(s[4 * 33], s[5 * 33]); o.w = cvtpk(s[6 * 33], s[7 * 33]);
    *(u32x4*)(dst + (size_t)n * ldt + 8 * cc) = o; }
  LDS_WAIT(); asm volatile("" ::: "memory");
}
struct Args { const float* in[10]; float* out; unsigned char* ws; };

__device__ __forceinline__ void p0_prologue(const Args& a, LAS unsigned char* ldsb, int G, int c, const int wid_s) {
  int tid_ = MYTID(wid_s); asm volatile("" : "+v"(tid_)); const int tid = tid_, wid = tid >> 6, lane = tid & 63;
  const float* x = a.in[0]; const float* norm_g = a.in[1]; const float* w_in = a.in[2]; const float* w_ap = a.in[5]; const float* w_fp = a.in[6]; const float* w_mg = a.in[7]; const float* w_out = a.in[9];
  bf16_t* W1T = (bf16_t*)(a.ws + WS_W1T); bf16_t* WCAT = (bf16_t*)(a.ws + WS_WCAT); bf16_t* WOUT = (bf16_t*)(a.ws + WS_WOUT); bf16_t* TAB = (bf16_t*)(a.ws + WS_TAB); bf16_t* H = (bf16_t*)(a.ws + WS_AF);
  LAS float* scr = (LAS float*)(ldsb + wid * 16384); LAS float* ct = scr + 2112; LAS float* st = ct + 128;
  ct[lane] = cos_rev((float)lane * (1.0f / 128.0f)); ct[lane + 64] = cos_rev((float)(lane + 64) * (1.0f / 128.0f));
  st[lane] = sin_rev((float)lane * (1.0f / 128.0f)); st[lane + 64] = sin_rev((float)(lane + 64) * (1.0f / 128.0f));
  LDS_WAIT(); asm volatile("" ::: "memory");
  const int gw = wid * G + c, NGW = 8 * G;
  constexpr int I0 = 2048, I1 = 1280, I2 = 256, I3 = 1024, I4 = 512, I5 = 256, I6 = 512, NITEMS = I0 + I1 + I2 + I3 + I4 + I5 + I6;
  for (int it = gw; it < NITEMS; it += NGW) {
    int r = it;
    if (r < I0) {
      const int kb = r >> 5, nb = r & 31, k0 = 16 * kb, n0 = 32 * nb, part = n0 >> 9, g = (n0 >> 7) & 3, cp0 = n0 & 127;
      const float* wrow = w_in + (size_t)k0 * 3584 + 2560 + g * 128; const LAS float* tb = part ? st : ct; const float sgn = part ? -1.f : 1.f;
      tr_item16([&](int kk, int nn) { const float* wr_ = wrow + (size_t)kk * 3584; const int cp = cp0 + nn; float s = 0.f;
#pragma unroll 8
          for (int cc = 0; cc < 128; ++cc) s += wr_[cc] * tb[(cc * cp) & 127];
          return s * sgn; }, W1T + (size_t)(C_ZR + n0) * 1024 + k0, 1024, scr, lane);
      continue; } r -= I0;
    if (r < I1) { const int kb = r / 80, nb = r % 80, k0 = 64 * kb, n0 = 32 * nb; const float* src = w_in + (size_t)k0 * 3584 + n0;
      tr_item([&](int kk, int nn) { return src[(size_t)kk * 3584 + nn]; }, W1T + (size_t)n0 * 1024 + k0, 1024, scr, lane); continue; } r -= I1;
    if (r < I2) { const int kb = r / 16, nb = r % 16, k0 = 64 * kb, n0 = 32 * nb; const float* src = w_in + (size_t)k0 * 3584 + 3072 + n0;
      tr_item([&](int kk, int nn) { return src[(size_t)kk * 3584 + nn]; }, W1T + (size_t)(C_ZF + n0) * 1024 + k0, 1024, scr, lane); continue; } r -= I2;
    if (r < I3) { const int kb = r / 64, nb = r % 64, k0 = 64 * kb, n0 = 32 * nb; const float* src = w_mg + (size_t)k0 * 2048 + n0;
      tr_item([&](int kk, int nn) { return src[(size_t)kk * 2048 + nn]; }, W1T + (size_t)(C_G + n0) * 1024 + k0, 1024, scr, lane); continue; } r -= I3;
    if (r < I4) { const int kb = r / 32, nb = r % 32, k0 = 64 * kb, n0 = 32 * nb; const float* src = w_ap + (size_t)k0 * 1024 + n0;
      tr_item([&](int kk, int nn) { return src[(size_t)kk * 1024 + nn]; }, WCAT + (size_t)n0 * 1536 + k0, 1536, scr, lane); continue; } r -= I4;
    if (r < I5) { const int kb = r / 32, nb = r % 32, k0 = 64 * kb, n0 = 32 * nb; const float* src = w_fp + (size_t)k0 * 1024 + n0;
      tr_item([&](int kk, int nn) { return src[(size_t)kk * 1024 + nn]; }, WCAT + (size_t)n0 * 1536 + 1024 + k0, 1536, scr, lane); continue; } r -= I5;
    { const int kb = r / 32, nb = r % 32, k0 = 64 * kb, n0 = 32 * nb; const float* src = w_out + (size_t)k0 * 1024 + n0;
      tr_item([&](int kk, int nn) { return src[(size_t)kk * 1024 + nn]; }, WOUT + (size_t)n0 * 1024 + k0, 1024, scr, lane); }
  }
  if (c == 0 && tid == 0) { const float* kg_ = a.in[4]; float gm = 0.f; for (int i = 0; i < 128; ++i) gm = fmaxf(gm, fabsf(kg_[i]));
    *(float*)(a.ws + WS_TAB + 262144) = gm * 11.313708499f * 1.02f; }
  for (int e = c * 512 + tid; e < 256 * 256 + 128 * 256; e += G * 512) {
    float v;
    if (e < 65536) { const int m = e >> 8, k = e & 255, w = m >> 5, i = m & 31, k1 = 16 * w + (i & 15), im = i >> 4, s1 = k & 127, pt = k >> 7;
      const float rev = (float)((k1 * s1) & 127) * (1.0f / 128.0f); const float cs = cos_rev(rev), sn = sin_rev(rev);
      v = (im == 0) ? (pt == 0 ? cs : sn) : (pt == 0 ? -sn : cs); }
    else { const int e2 = e - 65536, k2 = e2 >> 8, k = e2 & 255, s2 = k & 127, pt = k >> 7;
      const float rev = (float)((k2 * s2) & 127) * (1.0f / 128.0f); v = pt == 0 ? cos_rev(rev) : sin_rev(rev); }
    TAB[e] = f2bf(v);
  }
  f32x4 gn[4];
#pragma unroll
  for (int q = 0; q < 4; ++q) gn[q] = *(const f32x4*)(norm_g + 256 * q + 4 * lane);
  for (int m0 = gw * 4; m0 < MROWS; m0 += NGW * 4) {
    f32x4 v[4][4]; float ss[4];
#pragma unroll
    for (int rr = 0; rr < 4; ++rr) { const f32x4* xr = (const f32x4*)(x + (size_t)(m0 + rr) * DM) + lane;
#pragma unroll
      for (int q = 0; q < 4; ++q) v[rr][q] = xr[64 * q]; }
#pragma unroll
    for (int rr = 0; rr < 4; ++rr) { float s = 0.f;
#pragma unroll
      for (int q = 0; q < 4; ++q) s += (v[rr][q].x * v[rr][q].x + v[rr][q].y * v[rr][q].y) + (v[rr][q].z * v[rr][q].z + v[rr][q].w * v[rr][q].w);
      ss[rr] = s; }
#pragma unroll
    for (int o = 1; o < 64; o <<= 1) {
#pragma unroll
      for (int rr = 0; rr < 4; ++rr) ss[rr] += __shfl_xor(ss[rr], o); }
#pragma unroll
    for (int rr = 0; rr < 4; ++rr) { const float rstd = __builtin_amdgcn_rsqf(ss[rr] * (1.0f / DM) + NORM_EPS);
      u32x2* o8 = (u32x2*)(H + (size_t)(m0 + rr) * DM) + lane;
#pragma unroll
      for (int q = 0; q < 4; ++q) { u32x2 w; w.x = cvtpk(v[rr][q].x * rstd * gn[q].x, v[rr][q].y * rstd * gn[q].y); w.y = cvtpk(v[rr][q].z * rstd * gn[q].z, v[rr][q].w * rstd * gn[q].w); o8[64 * q] = w; } }
  }
}

#define XB_TMO      128
#define XB_XCNT(j)  (256  + 64 * (j))
#define XB_XSUB(j)  (1280 + 64 * (j))
#define XB_XGEN(j)  (2304 + 64 * (j))
#define XB_TOP      3328
#define XB_TOPGEN   3392
#define XCD_BAR_WORDS 3456
#define XB_SPIN_CAP (1u << 18)

__device__ __forceinline__ unsigned xb_ld(unsigned* p)              { return __hip_atomic_load(p, __ATOMIC_RELAXED, __HIP_MEMORY_SCOPE_AGENT); }
__device__ __forceinline__ unsigned xb_add(unsigned* p, unsigned v) { return __hip_atomic_fetch_add(p, v, __ATOMIC_RELAXED, __HIP_MEMORY_SCOPE_AGENT); }
__device__ __forceinline__ unsigned xb_xcc_id() { return (unsigned)__builtin_amdgcn_s_getreg((3 << 11) | 20) & 0xFu; }
#define XB_SPIN(cond, bar) do { unsigned _sp = 0; while (cond) { __builtin_amdgcn_s_sleep(1); \
    if ((++_sp & 255u) == 0u) { if (xb_ld(&(bar)[XB_TMO])) break; if (_sp > XB_SPIN_CAP) { atomicAdd(&(bar)[XB_TMO], 1u); break; } } } } while (0)

struct XcdBarrier {
    unsigned* bar; unsigned x;
    volatile LAS unsigned* st;
};

__device__ __forceinline__ XcdBarrier xcd_barrier_post(unsigned* bar, volatile LAS unsigned* st, const bool t0) {
    XcdBarrier b; b.bar = bar; b.x = xb_xcc_id(); b.st = st;
    if (t0) (void)xb_add(&bar[XB_XCNT(b.x)], 1u);
    return b;
}
__device__ __forceinline__ void xcd_barrier_complete(unsigned* bar, unsigned x, unsigned& nloc, unsigned& nx) {
    const unsigned G = gridDim.x * gridDim.y * gridDim.z;
    unsigned sum, cnt, mine, sp = 0u;
    for (;;) {
        sum = 0u; cnt = 0u; mine = 0u;
#pragma unroll
        for (unsigned j = 0; j < 16; ++j) { const unsigned c = xb_ld(&bar[XB_XCNT(j)]); sum += c; cnt += (c > 0u) ? 1u : 0u; mine = (j == x) ? c : mine; }
        if (sum == G) break;
        __builtin_amdgcn_s_sleep(1);
        if ((++sp & 255u) == 0u) { if (xb_ld(&bar[XB_TMO])) break; if (sp > XB_SPIN_CAP) { atomicAdd(&bar[XB_TMO], 1u); break; } }
    }
    nloc = mine > 0u ? mine : 1u; nx = cnt > 0u ? cnt : 1u;
}

__device__ __forceinline__ void xcd_barrier(const XcdBarrier& b, const bool t0) {
    asm volatile("s_waitcnt vmcnt(0)" ::: "memory");
    __syncthreads();
    if (t0) {
        unsigned* bar = b.bar;
        __builtin_amdgcn_s_waitcnt(0);
        unsigned nloc = b.st[0], nx = b.st[1];
        if (nloc == 0u) { xcd_barrier_complete(bar, b.x, nloc, nx); b.st[0] = nloc; b.st[1] = nx; }
        const unsigned old = xb_add(&bar[XB_XSUB(b.x)], 1u);
        const unsigned gen = old / nloc;
        if (old + 1u == (gen + 1u) * nloc) {
            __builtin_amdgcn_fence(__ATOMIC_RELEASE, "agent");
            asm volatile("s_waitcnt vmcnt(0)" ::: "memory");
            const unsigned og = xb_add(&bar[XB_TOP], 1u);
            const unsigned tg = og / nx;
            if (og + 1u == (tg + 1u) * nx) xb_add(&bar[XB_TOPGEN], 1u);
            else XB_SPIN(xb_ld(&bar[XB_TOPGEN]) == tg, bar);
            __builtin_amdgcn_fence(__ATOMIC_ACQUIRE, "agent");
            xb_add(&bar[XB_XGEN(b.x)], 1u);
            asm volatile("s_waitcnt vmcnt(0)" ::: "memory");
        } else {
            XB_SPIN(xb_ld(&bar[XB_XGEN(b.x)]) == gen, bar);
            __builtin_amdgcn_fence(__ATOMIC_ACQUIRE, "agent");
            asm volatile("s_waitcnt vmcnt(0)" ::: "memory");
        }
    }
    __syncthreads();
}

__global__ void __launch_bounds__(512, 2) fwd_megakernel(Args a) {
  extern __shared__ __attribute__((aligned(16))) unsigned char lds[];
  cg::grid_group grid = cg::this_grid();
  const int G = gridDim.x, c = blockIdx.x, wid_s = __builtin_amdgcn_readfirstlane((int)threadIdx.x >> 6);
  bf16_t* P1 = (bf16_t*)(a.ws + WS_P1); bf16_t* AF = (bf16_t*)(a.ws + WS_AF);
#ifndef PH
#define PH 255
#endif
  unsigned* BAR = (unsigned*)(a.ws + WS_CTL); volatile LAS unsigned* bst = (volatile LAS unsigned*)((LAS unsigned char*)lds + 147200);
  { const int l0 = lane_id_asm(); if (wid_s == 0 && l0 < 2) bst[l0] = 0u; }
  __syncthreads();
  const XcdBarrier xbar = xcd_barrier_post(BAR, bst, wid_s == 0 && lane_id_asm() == 0);
#define GRID_BAR() xcd_barrier(xbar, wid_s == 0 && lane_id_asm() == 0)
  if (a.out == nullptr) grid.sync();
  if (PH & 1) p0_prologue(a, (LAS unsigned char*)lds, G, c, wid_s);
  GRID_BAR();
  if (PH & 2) { pg8::Gemm g{(const bf16_t*)(a.ws + WS_AF), (const bf16_t*)(a.ws + WS_W1T), MROWS, N1, DM, DM, DM}; pg8::StaticOrder S; S.init(MROWS, N1, G, c);
    pg8::EpiG1 E{P1, (bf16_t*)(a.ws + WS_GT), a.in[8]};
    pg8::gemm_phase<pg8::EpiG1, pg8::StaticOrder, false, true>((LAS unsigned char*)lds, g, S, E, wid_s); }
  GRID_BAR();
  if (PH & 4) att::fft_phase<1>(a.ws, (char*)lds, G, c, wid_s);
  if (PH & 64) qk_fix(a.ws, a.in[3], a.in[4], G, c, wid_s);
  GRID_BAR();
  if (PH & 128) att::fft_phase<2>(a.ws, (char*)lds, G, c, wid_s);
  const float kmaxg = *(const float*)(a.ws + WS_TAB + 262144);
  if (PH & 8) for (int it = c; it < 1024; it += G) {
    const int xx = it & 7, rest = it >> 3, bk = xx >> 1, qb = (xx & 1) * 32 + (rest & 31), hq = rest >> 5, kvh = bk & 1, h = kvh * 4 + hq, b = bk >> 1;
    const long row0 = (long)b * SEQ + qb * 256;
    att::attn_item(P1 + row0 * LDP + C_Q + h * 128, P1 + (long)b * SEQ * LDP + C_K + kvh * 128, P1 + (long)b * SEQ * LDP + C_V + kvh * 128,
                   P1 + row0 * LDP + C_ZA + h * 128, AF + row0 * LDAF + h * 128, SEQ, (char*)lds, wid_s, a.in[3], qb * 256, kmaxg);
    __syncthreads();
  }
  GRID_BAR();
  if (PH & 16) { pg8::Gemm g{AF, (const bf16_t*)(a.ws + WS_WCAT), MROWS, DM, LDAF, LDAF, LDAF}; pg8::StaticOrder S; S.init(MROWS, DM, G, c);
    pg8::EpiG3 E{(const bf16_t*)(a.ws + WS_GT), P1 + C_MG};
    pg8::gemm_phase<pg8::EpiG3, pg8::StaticOrder, true, true>((LAS unsigned char*)lds, g, S, E, wid_s); }
  GRID_BAR();
  if (PH & 32) { pg8::Gemm g{P1 + C_MG, (const bf16_t*)(a.ws + WS_WOUT), MROWS, DM, DM, LDP, DM}; pg8::StaticOrder S; S.init(MROWS, DM, G, c);
    pg8::EpiG4 E{a.in[0], a.out};
    pg8::gemm_phase<pg8::EpiG4, pg8::StaticOrder, true, true>((LAS unsigned char*)lds, g, S, E, wid_s); }
}

extern "C" void kernel_launch(void* const* d_in, const int* in_sizes, int n_in, void* d_out, int out_size, void* d_ws, size_t ws_size, hipStream_t stream) {
  static int grid = 0;
  if (grid == 0) {
    if (n_in != 10 || in_sizes[0] != MROWS * DM || out_size != MROWS * DM || ws_size < WS_END) {
      fprintf(stderr, "kernel_launch: shape mismatch n_in %d in0 %d out %d ws %zu (need %zu)\n", n_in, n_in > 0 ? in_sizes[0] : -1, out_size, ws_size, (size_t)WS_END); grid = -1; return; }
    int dev = 0, cus = 0, per_cu = 0;
    hipGetDevice(&dev); hipDeviceGetAttribute(&cus, hipDeviceAttributeMultiprocessorCount, dev);
    if (hipFuncSetAttribute((const void*)fwd_megakernel, hipFuncAttributeMaxDynamicSharedMemorySize, LDS_BYTES) != hipSuccess) { fprintf(stderr, "kernel_launch: hipFuncSetAttribute failed\n"); grid = -1; return; }
    if (hipOccupancyMaxActiveBlocksPerMultiprocessor(&per_cu, (const void*)fwd_megakernel, 512, LDS_BYTES) != hipSuccess || per_cu < 1) { fprintf(stderr, "kernel_launch: occupancy query gave %d\n", per_cu); per_cu = 1; }
    (void)hipGetLastError();
    grid = cus * per_cu;
  }
  if (grid < 0) return;
  if (hipMemsetAsync((char*)d_ws + WS_CTL, 0, XCD_BAR_WORDS * 4, stream) != hipSuccess) { fprintf(stderr, "kernel_launch: hipMemsetAsync of the barrier words failed\n"); return; }
  Args a{};
  for (int i = 0; i < 10; ++i) a.in[i] = (const float*)d_in[i];
  a.out = (float*)d_out; a.ws = (unsigned char*)d_ws;
  void* args[] = {&a};
  hipError_t e = hipLaunchCooperativeKernel((const void*)fwd_megakernel, dim3(grid), dim3(512), args, LDS_BYTES, stream);
  if (e != hipSuccess) fprintf(stderr, "kernel_launch: cooperative launch failed: %s (grid %d)\n", hipGetErrorString(e), grid);
}
```
